# Optimizing an MI355X kernel written in HIP

```python
import numpy as np
import jax
import jax.numpy as jnp
from jax import lax

D_MODEL = 4096
BATCH = 2
SEQ = 8192
DEPTH = 1

N_MEM = 256
N_BRANCH = 3
BRANCH_W = D_MODEL // 2
GLA_HEADS = 4
GLA_DV = BRANCH_W // GLA_HEADS
GLA_DK = GLA_DV // 2
GLA_K_W = GLA_HEADS * GLA_DK
GLA_LOWRANK = 16
GLA_TAU = 16.0
GLA_CHUNK = 64
NSA_HEADS = 16
NSA_GROUPS = 4
NSA_REP = NSA_HEADS // NSA_GROUPS
NSA_HD = BRANCH_W // NSA_HEADS
NSA_KV_W = NSA_GROUPS * NSA_HD
CMP_LEN = 32
CMP_STRIDE = 16
SEL_LEN = 64
SEL_TOPK = 16
WINDOW = 512
Q_BLOCK = 128
FORCE_SCORE = 1e4
MEM_HEADS = 4
MEM_HD = BRANCH_W // MEM_HEADS
LN_EPS = 1e-5
RMS_EPS = 1e-6
NEG_INF = -1e30
DEEPNORM_ALPHA = (2 * DEPTH) ** 0.25
DEEPNORM_BETA = (8 * DEPTH) ** -0.25

IN_SIZES = (
    GLA_K_W, GLA_K_W, BRANCH_W, BRANCH_W, GLA_LOWRANK,
    BRANCH_W, NSA_KV_W, NSA_KV_W, NSA_KV_W, NSA_KV_W, NSA_KV_W, NSA_KV_W,
    BRANCH_W, 3 * NSA_HEADS,
    BRANCH_W, BRANCH_W,
    N_BRANCH * D_MODEL,
)
D_IN = sum(IN_SIZES)

kernel_name = 'hybrid_gla_nsa_memory_deepnorm'


def alibi_slopes(n):
    return jnp.exp2(-8.0 * (jnp.arange(n, dtype=jnp.float32) + 1.0) / n)


def layer_norm(z, g, b):
    zf = z.astype(jnp.float32)
    mu = jnp.mean(zf, -1, keepdims=True)
    zc = zf - mu
    var = jnp.mean(zc * zc, -1, keepdims=True)
    return (zc * lax.rsqrt(var + LN_EPS) * g + b).astype(z.dtype)


def gla_mixer(q, k, v, a_lr, w_a2, b_a, norm_g):
    B, S, _ = q.shape
    H, DK, DV, C = GLA_HEADS, GLA_DK, GLA_DV, GLA_CHUNK
    N = S // C
    f32 = jnp.float32
    log_a = jax.nn.log_sigmoid((a_lr @ w_a2 + b_a).astype(f32)) / GLA_TAU

    def to_chunks(t, d):
        return t.astype(f32).reshape(B, N, C, H, d).transpose(1, 0, 3, 2, 4)

    qc = to_chunks(q, DK) * DK ** -0.5
    kc = to_chunks(k, DK)
    vc = to_chunks(v, DV)
    ac = to_chunks(log_a, DK)
    causal = jnp.tril(jnp.ones((C, C), dtype=bool))

    def step(state, inp):
        qn, kn, vn, an = inp
        bcum = jnp.cumsum(an, axis=-2)
        b_last = bcum[..., -1:, :]
        q_d = qn * jnp.exp(bcum)
        k_d = kn * jnp.exp(-bcum)
        att = jnp.where(causal, jnp.einsum('bhcd,bhjd->bhcj', q_d, k_d), 0.0)
        o = att @ vn + jnp.einsum('bhcd,bhde->bhce', q_d, state)
        k_end = kn * jnp.exp(b_last - bcum)
        state = jnp.exp(b_last[..., 0, :])[..., None] * state + jnp.einsum('bhcd,bhce->bhde', k_end, vn)
        return state, o

    s0 = jnp.zeros((B, H, DK, DV), f32)
    _, o = lax.scan(step, s0, (qc, kc, vc, ac))
    o = o.transpose(1, 0, 3, 2, 4).reshape(B, S, H, DV)
    o = o * lax.rsqrt(jnp.mean(o * o, -1, keepdims=True) + RMS_EPS) * norm_g.astype(f32)
    return o.reshape(B, S, H * DV)


def nsa_mixer(q, kc, vc, ks, vs, kw, vw, gate_logits, pe_k, pe_v, wk1, wk2, wv1, wv2):
    B, S, _ = q.shape
    G, R, HD = NSA_GROUPS, NSA_REP, NSA_HD
    f32 = jnp.float32
    q = q.reshape(B, S, G, R, HD) * HD ** -0.5
    kc, vc, ks, vs, kw, vw = [t.reshape(B, S, G, HD) for t in (kc, vc, ks, vs, kw, vw)]
    slopes = alibi_slopes(NSA_HEADS).reshape(G, R)

    n_cmp = (S - CMP_LEN) // CMP_STRIDE + 1
    tok_idx = jnp.arange(n_cmp)[:, None] * CMP_STRIDE + jnp.arange(CMP_LEN)[None, :]
    cmp_start = tok_idx[:, 0]
    cmp_end = tok_idx[:, -1]

    def compress(t, pe, w1, w2):
        blk = t[:, tok_idx] + pe[None, None, :, None, :]
        blk = blk.transpose(0, 1, 3, 2, 4).reshape(B, n_cmp, G, CMP_LEN * HD)
        return jax.nn.silu(blk @ w1) @ w2

    k_cmp = compress(kc, pe_k, wk1, wk2)
    v_cmp = compress(vc, pe_v, wv1, wv2)

    n_sel = S // SEL_LEN
    top_k = min(SEL_TOPK, n_sel)
    ks_blk = ks.reshape(B, n_sel, SEL_LEN, G, HD).transpose(0, 3, 1, 2, 4)
    vs_blk = vs.reshape(B, n_sel, SEL_LEN, G, HD).transpose(0, 3, 1, 2, 4)
    sel_start = jnp.arange(n_sel) * SEL_LEN
    overlap = ((cmp_start[:, None] < sel_start[None, :] + SEL_LEN)
               & (cmp_end[:, None] >= sel_start[None, :])).astype(f32)
    blk_ids = jnp.arange(n_sel)

    pad = ((0, 0), (WINDOW, 0), (0, 0), (0, 0))
    kw_p = jnp.pad(kw, pad)
    vw_p = jnp.pad(vw, pad)

    b_ix = jnp.arange(B)[:, None, None, None]
    g_ix = jnp.arange(G)[None, :, None, None]

    def attend_block(qb):
        start = qb * Q_BLOCK
        t = start + jnp.arange(Q_BLOCK)
        qq = lax.dynamic_slice_in_dim(q, start, Q_BLOCK, axis=1)

        dist_c = t[:, None] - cmp_end[None, :]
        ok_c = dist_c >= 0
        s_c = (jnp.einsum('bqgrd,bngd->bgrqn', qq, k_cmp).astype(f32)
               - slopes[:, :, None, None] * dist_c.astype(f32))
        s_c = jnp.where(ok_c, s_c, NEG_INF)
        p_c = jax.nn.softmax(s_c, axis=-1) * jnp.any(ok_c, -1)[:, None]
        o_cmp = jnp.einsum('bgrqn,bngd->bqgrd', p_c.astype(v_cmp.dtype), v_cmp)

        imp = jnp.einsum('bgrqn,nj->bgqj', p_c, overlap)
        cur = t // SEL_LEN
        forced = ((blk_ids[None, :] == 0) | (blk_ids[None, :] == cur[:, None])
                  | (blk_ids[None, :] == cur[:, None] - 1))
        causal_blk = sel_start[None, :] <= t[:, None]
        score = jnp.where(forced, FORCE_SCORE, jnp.where(causal_blk, imp, -1.0))
        _, sel = lax.top_k(score, top_k)
        k_g = ks_blk[b_ix, g_ix, sel]
        v_g = vs_blk[b_ix, g_ix, sel]
        pos = sel[..., None] * SEL_LEN + jnp.arange(SEL_LEN)
        dist_s = (t[None, None, :, None, None] - pos)[:, :, None]
        s_s = (jnp.einsum('bqgrd,bgqkld->bgrqkl', qq, k_g).astype(f32)
               - slopes[None, :, :, None, None, None] * dist_s.astype(f32))
        s_s = jnp.where(dist_s >= 0, s_s, NEG_INF).reshape(B, G, R, Q_BLOCK, top_k * SEL_LEN)
        p_s = jax.nn.softmax(s_s, axis=-1).reshape(B, G, R, Q_BLOCK, top_k, SEL_LEN)
        o_sel = jnp.einsum('bgrqkl,bgqkld->bqgrd', p_s.astype(v_g.dtype), v_g)

        kk = lax.dynamic_slice_in_dim(kw_p, start, Q_BLOCK + WINDOW, axis=1)
        vv = lax.dynamic_slice_in_dim(vw_p, start, Q_BLOCK + WINDOW, axis=1)
        s_pos = start - WINDOW + jnp.arange(Q_BLOCK + WINDOW)
        dist_w = t[:, None] - s_pos[None, :]
        ok_w = (dist_w >= 0) & (dist_w < WINDOW) & (s_pos[None, :] >= 0)
        s_w = (jnp.einsum('bqgrd,bkgd->bgrqk', qq, kk).astype(f32)
               - slopes[:, :, None, None] * dist_w.astype(f32))
        s_w = jnp.where(ok_w, s_w, NEG_INF)
        p_w = jax.nn.softmax(s_w, axis=-1)
        o_win = jnp.einsum('bgrqk,bkgd->bqgrd', p_w.astype(vv.dtype), vv)
        return o_cmp, o_sel, o_win

    o_cmp, o_sel, o_win = lax.map(attend_block, jnp.arange(S // Q_BLOCK))

    def unblock(o):
        return o.transpose(1, 0, 2, 3, 4, 5).reshape(B, S, NSA_HEADS, HD)

    g = jax.nn.sigmoid(gate_logits).reshape(B, S, NSA_HEADS, 3)
    o = (g[..., 0:1] * unblock(o_cmp) + g[..., 1:2] * unblock(o_sel)
         + g[..., 2:3] * unblock(o_win))
    return o.reshape(B, S, NSA_HEADS * HD)


def memory_attention(q, mem, w_kv):
    B, S, _ = q.shape
    M = mem.shape[1]
    kv = (mem @ w_kv).reshape(B, M, 2, MEM_HEADS, MEM_HD)
    k, v = kv[:, :, 0], kv[:, :, 1]
    q = q.reshape(B, S, MEM_HEADS, MEM_HD) * MEM_HD ** -0.5
    s = jnp.einsum('bshd,bmhd->bhsm', q, k).astype(jnp.float32)
    p = jax.nn.softmax(s, axis=-1).astype(v.dtype)
    return jnp.einsum('bhsm,bmhd->bshd', p, v).reshape(B, S, MEM_HEADS * MEM_HD)


def hybrid_layer(x, mem, w_in, b_merge, gla_w_a2, gla_b_a, gla_norm_g, nsa_pe_k, nsa_pe_v,
                 nsa_wk1, nsa_wk2, nsa_wv1, nsa_wv2, w_mem_kv, w_br_gla, w_br_nsa, w_br_mem,
                 w_out, ln_g, ln_b):
    B, S, D = x.shape
    h = x @ w_in
    (gq, gk, gv, gz, ga, nq, nkc, nvc, nks, nvs, nkw, nvw, nz, nbg, mq, mz, mrg) = jnp.split(
        h, np.cumsum(IN_SIZES)[:-1].tolist(), axis=-1)
    o_gla = gla_mixer(gq, gk, gv, ga, gla_w_a2, gla_b_a, gla_norm_g).astype(x.dtype)
    y_gla = (o_gla * jax.nn.silu(gz)) @ w_br_gla
    o_nsa = nsa_mixer(nq, nkc, nvc, nks, nvs, nkw, nvw, nbg, nsa_pe_k, nsa_pe_v,
                      nsa_wk1, nsa_wk2, nsa_wv1, nsa_wv2)
    y_nsa = (o_nsa * jax.nn.silu(nz)) @ w_br_nsa
    o_mem = memory_attention(mq, mem, w_mem_kv)
    y_mem = (o_mem * jax.nn.silu(mz)) @ w_br_mem
    a = jax.nn.sigmoid(mrg + b_merge).reshape(B, S, N_BRANCH, D)
    merged = a[:, :, 0] * y_gla + a[:, :, 1] * y_nsa + a[:, :, 2] * y_mem
    out = merged @ w_out
    return layer_norm(DEEPNORM_ALPHA * x + out, ln_g, ln_b)


def setup_inputs(seed: int = 0) -> dict:
    key = jax.random.key(seed)
    ks = jax.random.split(key, 20)
    L, D = DEPTH, D_MODEL

    def nrm(k, shape, scale):
        return jax.random.normal(k, shape, jnp.float32) * scale

    return {
        'x': nrm(ks[0], (BATCH, SEQ, D), 1.0),
        'mem': nrm(ks[1], (BATCH, N_MEM, D), 1.0),
        'w_in': nrm(ks[2], (L, D, D_IN), D ** -0.5),
        'b_merge': nrm(ks[3], (L, N_BRANCH * D), 0.01),
        'gla_w_a2': nrm(ks[4], (L, GLA_LOWRANK, GLA_K_W), GLA_LOWRANK ** -0.5),
        'gla_b_a': nrm(ks[5], (L, GLA_K_W), 0.1),
        'gla_norm_g': 1.0 + nrm(ks[6], (L, GLA_DV), 0.02),
        'nsa_pe_k': nrm(ks[7], (L, CMP_LEN, NSA_HD), 0.1),
        'nsa_pe_v': nrm(ks[8], (L, CMP_LEN, NSA_HD), 0.1),
        'nsa_wk1': nrm(ks[9], (L, CMP_LEN * NSA_HD, NSA_HD), (CMP_LEN * NSA_HD) ** -0.5),
        'nsa_wk2': nrm(ks[10], (L, NSA_HD, NSA_HD), NSA_HD ** -0.5),
        'nsa_wv1': nrm(ks[11], (L, CMP_LEN * NSA_HD, NSA_HD), (CMP_LEN * NSA_HD) ** -0.5),
        'nsa_wv2': nrm(ks[12], (L, NSA_HD, NSA_HD), NSA_HD ** -0.5),
        'w_mem_kv': nrm(ks[13], (L, D, 2 * MEM_HEADS * MEM_HD), D ** -0.5),
        'w_br_gla': nrm(ks[14], (L, BRANCH_W, D), BRANCH_W ** -0.5 * DEEPNORM_BETA),
        'w_br_nsa': nrm(ks[15], (L, BRANCH_W, D), BRANCH_W ** -0.5 * DEEPNORM_BETA),
        'w_br_mem': nrm(ks[16], (L, BRANCH_W, D), BRANCH_W ** -0.5 * DEEPNORM_BETA),
        'w_out': nrm(ks[17], (L, D, D), D ** -0.5 * DEEPNORM_BETA),
        'ln_g': 1.0 + nrm(ks[18], (L, D), 0.02),
        'ln_b': nrm(ks[19], (L, D), 0.02),
    }


def reference(x, mem, w_in, b_merge, gla_w_a2, gla_b_a, gla_norm_g, nsa_pe_k, nsa_pe_v,
              nsa_wk1, nsa_wk2, nsa_wv1, nsa_wv2, w_mem_kv, w_br_gla, w_br_nsa, w_br_mem,
              w_out, ln_g, ln_b):
    for l in range(DEPTH):
        x = hybrid_layer(x, mem, w_in[l], b_merge[l], gla_w_a2[l], gla_b_a[l], gla_norm_g[l],
                         nsa_pe_k[l], nsa_pe_v[l], nsa_wk1[l], nsa_wk2[l], nsa_wv1[l], nsa_wv2[l],
                         w_mem_kv[l], w_br_gla[l], w_br_nsa[l], w_br_mem[l], w_out[l],
                         ln_g[l], ln_b[l])
    return x
```

```cpp
#include <hip/hip_runtime.h>
#include <cstdio>
#include <cstdint>

#ifndef MK_SINGLE
#define MK_SINGLE 1
#endif

#define DI __device__ __forceinline__
#define LAS __attribute__((address_space(3)))
#define GAS __attribute__((address_space(1)))
typedef unsigned short bf16;
typedef short bf16x8 __attribute__((ext_vector_type(8)));
typedef short s16x4 __attribute__((ext_vector_type(4)));
typedef short v4i16_t __attribute__((ext_vector_type(4)));
typedef float f32x4 __attribute__((ext_vector_type(4)));
typedef float f32x2_t __attribute__((ext_vector_type(2)));
typedef __bf16 bf16x2_t __attribute__((ext_vector_type(2)));
typedef unsigned u32x4 __attribute__((ext_vector_type(4)));
typedef unsigned u32x2 __attribute__((ext_vector_type(2)));
typedef GAS unsigned gu32;
#define RLX_AGENT __ATOMIC_RELAXED, __HIP_MEMORY_SCOPE_AGENT

constexpr int DM = 4096, BATCH = 2, SEQ = 8192, M = BATCH * SEQ;
constexpr int D_IN = 29760;
constexpr int NP = 29952;
constexpr int H_GQ = 0, H_GK = 1024, H_GV = 2048, H_GZ = 4096, H_NQ = 6144, H_NKC = 8192, H_NVC = 8704, H_NKS = 9216, H_NVS = 9728,
              H_NKW = 10240, H_NVW = 10752, H_NZ = 11264, H_MQ = 13312, H_MZ = 15360, H_MRG = 17408, H_SM = 29696;
constexpr float ALPHA = 1.189207115002721f;
constexpr float LN_EPS = 1e-5f, RMS_EPS = 1e-6f;
constexpr float NEG = -1e30f;

__host__ __device__ __forceinline__ int win_src_col(int n) {
    if (n < 6144) return n;
    if (n < 13312) return n + 16;
    if (n < 29696) return n + 64;
    if (n < 29712) return n - 29696 + 6144;
    if (n < 29760) return n - 29712 + 13328;
    return -1;
}

constexpr size_t MiB = 1u << 20;
constexpr size_t WS_CTL = 0, CTL_ZERO_BYTES = 64 * 1024;
constexpr size_t WS_C1 = 512 * 1024;
constexpr size_t WS_WINT = 2 * MiB;
constexpr size_t WS_WKVT = 236 * MiB;
constexpr size_t WS_XB = 268 * MiB;
constexpr size_t WS_MEMB = 396 * MiB;
constexpr size_t WS_H = 400 * MiB;
constexpr size_t WS_KVMEM = 1336 * MiB;
constexpr size_t WS_WBRT = 1340 * MiB;
constexpr size_t WS_WOUTT = 1388 * MiB;
constexpr size_t WS_W1T = 1420 * MiB;
constexpr size_t WS_W2T = 1422 * MiB;
constexpr size_t WS_CMP = 1423 * MiB;
constexpr size_t WS_GDEC = 1425 * MiB;
constexpr size_t WS_QD = 1426 * MiB;
constexpr size_t WS_KEND = 1458 * MiB;
constexpr size_t WS_MERGED = 1490 * MiB;
constexpr size_t WS_END = 1618 * MiB;
constexpr size_t WS_GATED = 2 * MiB;
constexpr size_t WS_GO = 268 * MiB;
static_assert(WS_GATED + 3 * (size_t)M * 2048 * 2 <= WS_WKVT && WS_GO + (size_t)M * 2048 * 4 <= WS_MEMB, "overlays");
constexpr int CW_Q2 = 64, CW_Q3 = 128;
constexpr int CW_BAR = 4096;

constexpr int LDS_BYTES = 155648;
constexpr int MISC_OFF = LDS_BYTES - 256;
constexpr int NWAVES = 8;

DI float bflo(unsigned w) { return __uint_as_float(w << 16); }
DI float bfhi(unsigned w) { return __uint_as_float(w & 0xffff0000u); }
DI float bf2f(bf16 b) { return __uint_as_float(((unsigned)b) << 16); }
DI unsigned cvtpk(float lo, float hi) { f32x2_t v = {lo, hi}; bf16x2_t b = __builtin_convertvector(v, bf16x2_t); return __builtin_bit_cast(unsigned, b); }
DI f32x4 mfma16(bf16x8 a, bf16x8 b, f32x4 c) { return __builtin_amdgcn_mfma_f32_16x16x32_bf16(a, b, c, 0, 0, 0); }
DI bf16x8 pack2(f32x4 a, f32x4 b) { u32x4 p; p.x = cvtpk(a[0], a[1]); p.y = cvtpk(a[2], a[3]); p.z = cvtpk(b[0], b[1]); p.w = cvtpk(b[2], b[3]); return __builtin_bit_cast(bf16x8, p); }
DI s16x4 trread(const LAS char* p) { return __builtin_bit_cast(s16x4, __builtin_amdgcn_ds_read_tr16_b64_v4i16((LAS v4i16_t*)p)); }
DI bf16x8 tr_frag(const LAS char* img, int RS, int m0, int kA, int kB, int lane) {
    const int q = (lane & 15) >> 2, p = lane & 3;
    const s16x4 lo = trread(img + (kA + q) * RS + (m0 + 4 * p) * 2);
    const s16x4 hi = trread(img + (kB + q) * RS + (m0 + 4 * p) * 2);
    return __builtin_shufflevector(lo, hi, 0, 1, 2, 3, 4, 5, 6, 7);
}
DI float wave_sum(float v) {
#pragma unroll
    for (int o = 1; o < 64; o <<= 1) v += __shfl_xor(v, o);
    return v;
}
DI float sigmoidf_(float x) { return 1.f / (1.f + __expf(-x)); }
DI float siluf_(float x) { return x / (1.f + __expf(-x)); }
template <int ROWS, int CHUNKS> DI void g2l_tile(LAS char* dst, int dstRS, const char* src, size_t srcRS, int tid) {
#pragma unroll
    for (int it = 0; it < (ROWS * CHUNKS + 511) / 512; ++it) { const int idx = tid + it * 512;
        if ((ROWS * CHUNKS) % 512 == 0 || idx < ROWS * CHUNKS) { const int r = idx / CHUNKS, c = idx % CHUNKS;
            *(LAS u32x4*)(dst + r * dstRS + c * 16) = *(const u32x4*)(src + (size_t)r * srcRS + c * 16); } }
}
template <int ROWS, int CHUNKS> DI void pf_load(u32x4 (&v)[(ROWS * CHUNKS + 511) / 512], const char* src, size_t srcRS, int tid) {
#pragma unroll
    for (int it = 0; it < (ROWS * CHUNKS + 511) / 512; ++it) { const int idx = tid + it * 512;
        if ((ROWS * CHUNKS) % 512 == 0 || idx < ROWS * CHUNKS) { const int r = idx / CHUNKS, c = idx % CHUNKS; v[it] = *(const u32x4*)(src + (size_t)r * srcRS + c * 16); } }
}
template <int ROWS, int CHUNKS> DI void pf_store(const u32x4 (&v)[(ROWS * CHUNKS + 511) / 512], LAS char* dst, int dstRS, int tid) {
#pragma unroll
    for (int it = 0; it < (ROWS * CHUNKS + 511) / 512; ++it) { const int idx = tid + it * 512;
        if ((ROWS * CHUNKS) % 512 == 0 || idx < ROWS * CHUNKS) { const int r = idx / CHUNKS, c = idx % CHUNKS; *(LAS u32x4*)(dst + r * dstRS + c * 16) = v[it]; } }
}
namespace pg8 {
#define PG8_LAS __attribute__((address_space(3)))
typedef unsigned short bf16_t;
typedef short bf16x8 __attribute__((ext_vector_type(8)));
typedef float f32x4 __attribute__((ext_vector_type(4)));
typedef unsigned u32x4 __attribute__((ext_vector_type(4)));
constexpr int BM = 256, BK = 64, HALF = 128, HTB = HALF * BK * 2  , STAGE_BYTES = 8 * HTB, NXCD = 8, WGM = 8;

__host__ __device__ __forceinline__ int lds_byte(int r, int c) { const int st = (r >> 4) * 2 + (c >> 5), rr = r & 15, cc = c & 31, ob = rr * 64 + cc * 2; return st * 1024 + (ob ^ (((ob >> 9) & 1) << 5)); }
__host__ __device__ __forceinline__ void stage_rc(int b, int& R, int& C) { const int st = b / 1024, sb = b % 1024, swz = sb ^ (((sb >> 9) & 1) << 5); R = (st >> 1) * 16 + swz / 64; C = (st & 1) * 32 + (swz % 64) / 2; }
__host__ __device__ __forceinline__ int perm32(int rho) { const int n = rho >> 4, i = rho & 15; return 8 * (i >> 2) + 4 * n + (i & 3); }

struct Unit { int pm, pn; };
struct Gemm { const bf16_t* A; const bf16_t* Bt; int M, N, K; };

struct StaticOrder {
    int nM, nN, nwg, G, c;
    __host__ __device__ void init(int M, int N, int G_, int c_) { nM = M / BM; nN = N / BM; nwg = nM * nN; G = G_; c = c_; }
    __host__ __device__ bool next(int i, Unit& u) const {
        const long L = (long)i * G + c; if (L >= nwg) return false;
        int wgid = (int)L; { const int q = nwg / NXCD, r = nwg % NXCD, xcd = wgid % NXCD, off = wgid / NXCD; wgid = (xcd < r ? xcd * (q + 1) : r * (q + 1) + (xcd - r) * q) + off; }
        const int nig = WGM * nN, gid = wgid / nig, fm = gid * WGM, gsz = (nM - fm) < WGM ? (nM - fm) : WGM;
        u.pm = fm + ((wgid % nig) % gsz); u.pn = (wgid % nig) / gsz; return true;
    }
    __device__ __forceinline__ void a_ready(const Unit&) const {}
    __device__ __forceinline__ void done(const Unit&) const {}
};

__device__ __forceinline__ unsigned cvt_pk_bf16(float lo, float hi) { unsigned r; asm volatile("v_cvt_pk_bf16_f32 %0, %1, %2" : "=v"(r) : "v"(lo), "v"(hi)); return r; }
typedef float f32x2 __attribute__((ext_vector_type(2)));
struct EpiStore {
    static constexpr bool PERM = true, AFTER_DRAIN = false;
    bf16_t* O; int ldc;
    __device__ __forceinline__ void operator()(const f32x4 (&acc)[2][2][4][2], const Unit& u, int wr, int wc, int fr, int fq) const {
        const int row0 = u.pm * BM + wr * 64 + fr, col0 = u.pn * BM + wc * 32 + 8 * fq;
#pragma unroll
        for (int ai = 0; ai < 2; ++ai)
#pragma unroll
            for (int m = 0; m < 4; ++m) { bf16_t* rowp = O + (size_t)(row0 + ai * HALF + m * 16) * ldc + col0;
#pragma unroll
                for (int bj = 0; bj < 2; ++bj) { const f32x4 v0 = acc[ai][bj][m][0], v1 = acc[ai][bj][m][1];
                    u32x4 w; w.x = cvt_pk_bf16(v0[0], v0[1]); w.y = cvt_pk_bf16(v0[2], v0[3]); w.z = cvt_pk_bf16(v1[0], v1[1]); w.w = cvt_pk_bf16(v1[2], v1[3]);
                    *(u32x4*)(rowp + bj * HALF) = w; } }
    }
};
struct EpiMerge {
    static constexpr bool PERM = true, AFTER_DRAIN = false;
    const bf16_t* Hh; int ldh, mrg_col; const float* bmerge; bf16_t* MG;
    __device__ __forceinline__ void operator()(const f32x4 (&acc)[2][2][4][2], const Unit& u, int wr, int wc, int fr, int fq) const {
        const int br = u.pm >> 6, pm = u.pm & 63, pn = u.pn & 15;
        const int row0 = pm * BM + wr * 64 + fr, col0 = pn * BM + wc * 32 + 8 * fq;
#pragma unroll
        for (int bj = 0; bj < 2; ++bj) { const int col = col0 + bj * HALF;
            const f32x4 b0 = *(const f32x4*)(bmerge + br * 4096 + col), b1 = *(const f32x4*)(bmerge + br * 4096 + col + 4);
#pragma unroll
            for (int ai = 0; ai < 2; ++ai)
#pragma unroll
                for (int m = 0; m < 4; ++m) { const int row = row0 + ai * HALF + m * 16;
                    const u32x4 gr = *(const u32x4*)(Hh + (size_t)row * ldh + mrg_col + br * 4096 + col);
                    f32x4 v0 = acc[ai][bj][m][0], v1 = acc[ai][bj][m][1];
                    f32x4 g0, g1;
                    g0[0] = __uint_as_float(gr.x << 16) + b0[0]; g0[1] = __uint_as_float(gr.x & 0xffff0000u) + b0[1]; g0[2] = __uint_as_float(gr.y << 16) + b0[2]; g0[3] = __uint_as_float(gr.y & 0xffff0000u) + b0[3];
                    g1[0] = __uint_as_float(gr.z << 16) + b1[0]; g1[1] = __uint_as_float(gr.z & 0xffff0000u) + b1[1]; g1[2] = __uint_as_float(gr.w << 16) + b1[2]; g1[3] = __uint_as_float(gr.w & 0xffff0000u) + b1[3];
#pragma unroll
                    for (int j = 0; j < 4; ++j) { v0[j] = v0[j] / (1.f + __expf(-g0[j])); v1[j] = v1[j] / (1.f + __expf(-g1[j])); }
                    bf16_t* mp = MG + (size_t)row * 4096 + col;
                    if (br > 0) {
                        const unsigned long long o0 = __hip_atomic_load((const unsigned long long*)mp, __ATOMIC_RELAXED, __HIP_MEMORY_SCOPE_AGENT);
                        const unsigned long long o1 = __hip_atomic_load((const unsigned long long*)mp + 1, __ATOMIC_RELAXED, __HIP_MEMORY_SCOPE_AGENT);
                        const unsigned a0 = (unsigned)o0, a1 = (unsigned)(o0 >> 32), a2 = (unsigned)o1, a3 = (unsigned)(o1 >> 32);
                        v0[0] += __uint_as_float(a0 << 16); v0[1] += __uint_as_float(a0 & 0xffff0000u); v0[2] += __uint_as_float(a1 << 16); v0[3] += __uint_as_float(a1 & 0xffff0000u);
                        v1[0] += __uint_as_float(a2 << 16); v1[1] += __uint_as_float(a2 & 0xffff0000u); v1[2] += __uint_as_float(a3 << 16); v1[3] += __uint_as_float(a3 & 0xffff0000u);
                    }
                    u32x4 w; w.x = cvt_pk_bf16(v0[0], v0[1]); w.y = cvt_pk_bf16(v0[2], v0[3]); w.z = cvt_pk_bf16(v1[0], v1[1]); w.w = cvt_pk_bf16(v1[2], v1[3]);
                    *(u32x4*)mp = w; } }
    }
};
struct EpiOut {
    static constexpr bool PERM = false, AFTER_DRAIN = false;
    const float* X; float* C; float alpha;
    __device__ __forceinline__ void operator()(const f32x4 (&acc)[2][2][4][2], const Unit& u, int wr, int wc, int fr, int fq) const {
        const int row0 = u.pm * BM + wr * 64 + fr, col0 = u.pn * BM + wc * 32 + 4 * fq;
#pragma unroll
        for (int ai = 0; ai < 2; ++ai)
#pragma unroll
            for (int m = 0; m < 4; ++m) { const size_t off = (size_t)(row0 + ai * HALF + m * 16) * 4096 + col0;
#pragma unroll
                for (int bj = 0; bj < 2; ++bj)
#pragma unroll
                    for (int n = 0; n < 2; ++n) { const f32x4 xv = *(const f32x4*)(X + off + bj * HALF + n * 16); *(f32x4*)(C + off + bj * HALF + n * 16) = xv * alpha + acc[ai][bj][m][n]; } }
    }
};
struct MergeOrder {
    StaticOrder so;
    __host__ __device__ void init(int G_, int c_) { so.init(16384, 4096, G_, c_); }
    __host__ __device__ bool next(int i, Unit& u) const { Unit t; if (!so.next(i / 3, t)) return false; const int br = i % 3; u.pm = br * 64 + t.pm; u.pn = br * 16 + t.pn; return true; }
    __device__ __forceinline__ void a_ready(const Unit&) const {}
    __device__ __forceinline__ void done(const Unit&) const {}
};
template <class Epi, class Sched, bool ALIGN_EPI = false, bool SP2 = false>
__device__ __forceinline__ void gemm_phase(PG8_LAS unsigned char* lds, const Gemm g, const Sched& S, const Epi& E) {
    const int tid = threadIdx.x, wid = __builtin_amdgcn_readfirstlane(tid >> 6), lane = tid & 63, wr = wid >> 2, wc = wid & 3, fr = lane & 15, fq = lane >> 4;
    const int K = g.K, nt = K / BK;
    unsigned voffA[2], voffB[2];
#pragma unroll
    for (int i = 0; i < 2; ++i) { int R, C; stage_rc(tid * 16 + i * 8192, R, C); const int Rb = Epi::PERM ? ((R & ~31) + perm32(R & 31)) : R;
        voffA[i] = (unsigned)(R * K + C) * 2u; voffB[i] = (unsigned)(Rb * K + C) * 2u; }
    const size_t kstep = (size_t)(BK * 2);
    const size_t hstep = (size_t)HALF * K * 2;
    const size_t tstep = 2 * hstep;
    const unsigned ldsw = (unsigned)wid * 1024u;
    const int aoff = lds_byte(wr * 64 + fr, fq * 8), boff = lds_byte(wc * 32 + fr, fq * 8);
#define PG8_SA(b, h) (((b) * 2 + (h)) * HTB)
#define PG8_SB(b, h) ((4 + (b) * 2 + (h)) * HTB)
#define PG8_STAGE(bufoff, gbase, voff) do { _Pragma("unroll") for (int _i = 0; _i < 2; ++_i) \
        __builtin_amdgcn_global_load_lds((const unsigned*)((const char*)(gbase) + (voff)[_i]), (PG8_LAS unsigned*)(lds + (bufoff) + ldsw + _i * 8192), 16, 0, 0); } while (0)
#define PG8_LDA(dst, b, h) do { _Pragma("unroll") for (int m = 0; m < 4; ++m) _Pragma("unroll") for (int k = 0; k < 2; ++k) dst[m][k] = *(const PG8_LAS bf16x8*)(lds + PG8_SA(b, h) + aoff + m * 2048 + k * 1024); } while (0)
#define PG8_LDB(dst, b, h) do { _Pragma("unroll") for (int n = 0; n < 2; ++n) _Pragma("unroll") for (int k = 0; k < 2; ++k) dst[n][k] = *(const PG8_LAS bf16x8*)(lds + PG8_SB(b, h) + boff + n * 2048 + k * 1024); } while (0)
#define PG8_MMA(ai, bj, At, Bt) do { __builtin_amdgcn_s_setprio(1); _Pragma("unroll") for (int m = 0; m < 4; ++m) _Pragma("unroll") for (int n = 0; n < 2; ++n) _Pragma("unroll") for (int k = 0; k < 2; ++k) \
        acc[ai][bj][m][n] = __builtin_amdgcn_mfma_f32_16x16x32_bf16(Bt[n][k], At[m][k], acc[ai][bj][m][n], 0, 0, 0); __builtin_amdgcn_s_setprio(0); } while (0)
#define PG8_WAIT_V(n) asm volatile("s_waitcnt vmcnt(" #n ")" ::: "memory")
#define PG8_WAIT_L(n) asm volatile("s_waitcnt lgkmcnt(" #n ")" ::: "memory")
#define PG8_BAR __builtin_amdgcn_s_barrier()
#define PG8_SCHED __builtin_amdgcn_sched_barrier(0)
    Unit cur, nxt; int ui = 0;
    if (!S.next(0, cur)) return;
    f32x4 acc[2][2][4][2];
#pragma unroll
    for (int a = 0; a < 2; ++a)
#pragma unroll
        for (int b = 0; b < 2; ++b)
#pragma unroll
            for (int m = 0; m < 4; ++m)
#pragma unroll
                for (int n = 0; n < 2; ++n) acc[a][b][m][n] = (f32x4){0.f, 0.f, 0.f, 0.f};
    bf16x8 At[4][2], B0[2][2], B1[2][2];
    const char* cA = (const char*)g.A + (size_t)cur.pm * tstep; const char* cB = (const char*)g.Bt + (size_t)cur.pn * tstep;
    S.a_ready(cur);
    if constexpr (SP2) {
        PG8_STAGE(PG8_SB(0, 0), cB, voffB); PG8_STAGE(PG8_SB(0, 1), cB + hstep, voffB); PG8_STAGE(PG8_SA(0, 0), cA, voffA); PG8_STAGE(PG8_SA(0, 1), cA + hstep, voffA);
        if (wr == 1) PG8_BAR;
        PG8_WAIT_V(2); PG8_BAR;
        PG8_STAGE(PG8_SB(1, 0), cB + kstep, voffB); PG8_STAGE(PG8_SA(1, 0), cA + kstep, voffA); PG8_STAGE(PG8_SB(1, 1), cB + hstep + kstep, voffB);
        PG8_WAIT_V(6); PG8_BAR;
    } else {
        PG8_STAGE(PG8_SB(0, 0), cB, voffB); PG8_STAGE(PG8_SA(0, 0), cA, voffA); PG8_STAGE(PG8_SB(0, 1), cB + hstep, voffB); PG8_STAGE(PG8_SA(0, 1), cA + hstep, voffA);
        if (wr == 1) PG8_BAR;
        PG8_WAIT_V(4); PG8_BAR;
        PG8_STAGE(PG8_SB(1, 0), cB + kstep, voffB); PG8_STAGE(PG8_SA(1, 0), cA + kstep, voffA); PG8_STAGE(PG8_SB(1, 1), cB + hstep + kstep, voffB);
        PG8_WAIT_V(6); PG8_BAR;
    }
    for (;;) {
        const bool has_next = S.next(ui + 1, nxt);
        const char* nA = has_next ? (const char*)g.A + (size_t)nxt.pm * tstep : cA; const char* nB = has_next ? (const char*)g.Bt + (size_t)nxt.pn * tstep : cB;
        for (int t = 0; t < nt; t += 2) {
            const bool last = (t == nt - 2);
            const char* a1 = cA + (size_t)(t + 1) * kstep;
            const char* a2 = last ? nA : cA + (size_t)(t + 2) * kstep; const char* b2 = last ? nB : cB + (size_t)(t + 2) * kstep;
            const char* a3 = a2 + kstep; const char* b3 = b2 + kstep;
            if (last && has_next) S.a_ready(nxt);
            if constexpr (SP2) {
            PG8_LDB(B0, 0, 0); PG8_LDB(B1, 0, 1); PG8_SCHED; PG8_LDA(At, 0, 0); PG8_STAGE(PG8_SA(1, 1), a1 + hstep, voffA);
            PG8_WAIT_V(8); PG8_WAIT_L(0); PG8_BAR; PG8_MMA(0, 0, At, B0); PG8_MMA(0, 1, At, B1); PG8_BAR; PG8_SCHED;
            PG8_LDA(At, 0, 1); PG8_STAGE(PG8_SB(0, 0), b2, voffB); PG8_STAGE(PG8_SB(0, 1), b2 + hstep, voffB); PG8_STAGE(PG8_SA(0, 0), a2, voffA);
            PG8_WAIT_V(8); PG8_WAIT_L(0); PG8_BAR; PG8_MMA(1, 0, At, B0); PG8_MMA(1, 1, At, B1); PG8_BAR; PG8_SCHED;
            PG8_LDB(B0, 1, 0); PG8_LDB(B1, 1, 1); PG8_SCHED; PG8_LDA(At, 1, 0); PG8_STAGE(PG8_SA(0, 1), a2 + hstep, voffA);
            PG8_WAIT_V(8); PG8_WAIT_L(0); PG8_BAR; PG8_MMA(0, 0, At, B0); PG8_MMA(0, 1, At, B1); PG8_BAR; PG8_SCHED;
            PG8_LDA(At, 1, 1); PG8_STAGE(PG8_SB(1, 0), b3, voffB); PG8_STAGE(PG8_SB(1, 1), b3 + hstep, voffB); PG8_STAGE(PG8_SA(1, 0), a3, voffA);
            PG8_WAIT_V(8); PG8_WAIT_L(0); PG8_BAR; PG8_MMA(1, 0, At, B0); PG8_MMA(1, 1, At, B1); PG8_BAR; PG8_SCHED;
            } else {
            PG8_LDB(B0, 0, 0); PG8_SCHED; PG8_LDA(At, 0, 0); PG8_STAGE(PG8_SA(1, 1), a1 + hstep, voffA);
            PG8_WAIT_L(8); PG8_BAR; PG8_WAIT_L(0); PG8_MMA(0, 0, At, B0); PG8_BAR; PG8_SCHED;
            PG8_LDB(B1, 0, 1); PG8_STAGE(PG8_SB(0, 0), b2, voffB);
            PG8_BAR; PG8_WAIT_L(0); PG8_MMA(0, 1, At, B1); PG8_BAR;
            PG8_LDA(At, 0, 1); PG8_STAGE(PG8_SA(0, 0), a2, voffA);
            PG8_BAR; PG8_WAIT_L(0); PG8_MMA(1, 0, At, B0); PG8_BAR; PG8_SCHED;
            PG8_STAGE(PG8_SB(0, 1), b2 + hstep, voffB);
            PG8_WAIT_V(6); PG8_BAR; PG8_MMA(1, 1, At, B1); PG8_BAR;
            PG8_LDB(B0, 1, 0); PG8_SCHED; PG8_LDA(At, 1, 0); PG8_STAGE(PG8_SA(0, 1), a2 + hstep, voffA);
            PG8_WAIT_L(8); PG8_BAR; PG8_WAIT_L(0); PG8_MMA(0, 0, At, B0); PG8_BAR; PG8_SCHED;
            PG8_LDB(B1, 1, 1); PG8_STAGE(PG8_SB(1, 0), b3, voffB);
            PG8_BAR; PG8_WAIT_L(0); PG8_MMA(0, 1, At, B1); PG8_BAR;
            PG8_LDA(At, 1, 1); PG8_STAGE(PG8_SA(1, 0), a3, voffA);
            PG8_BAR; PG8_WAIT_L(0); PG8_MMA(1, 0, At, B0); PG8_BAR; PG8_SCHED;
            PG8_STAGE(PG8_SB(1, 1), b3 + hstep, voffB);
            PG8_WAIT_V(6); PG8_BAR; PG8_MMA(1, 1, At, B1); PG8_BAR;
            }
        }
        if constexpr (ALIGN_EPI) { if (wr == 0) PG8_BAR; }
        if constexpr (!Epi::AFTER_DRAIN) { E(acc, cur, wr, wc, fr, fq); S.done(cur); }
        if (!has_next) break;
#pragma unroll
        for (int a = 0; a < 2; ++a)
#pragma unroll
            for (int b = 0; b < 2; ++b)
#pragma unroll
                for (int m = 0; m < 4; ++m)
#pragma unroll
                    for (int n = 0; n < 2; ++n) acc[a][b][m][n] = (f32x4){0.f, 0.f, 0.f, 0.f};
        cur = nxt; cA = nA; cB = nB; ++ui;
        if constexpr (ALIGN_EPI) { if (wr == 1) PG8_BAR; }
    }
    PG8_WAIT_V(0);
    if constexpr (!ALIGN_EPI) { if (wr == 0) PG8_BAR; }
    PG8_BAR;
    if constexpr (Epi::AFTER_DRAIN) { E.fused(acc, cur, wr, wc, fr, fq, lds, wid, lane); S.done(cur); }
#undef PG8_SA
#undef PG8_SB
#undef PG8_STAGE
#undef PG8_LDA
#undef PG8_LDB
#undef PG8_MMA
#undef PG8_WAIT_V
#undef PG8_WAIT_L
#undef PG8_BAR
#undef PG8_SCHED
}
}
#define XB_TMO      128
#define XB_XCNT(j)  (256  + 64 * (j))
#define XB_XSUB(j)  (1280 + 64 * (j))
#define XB_XGEN(j)  (2304 + 64 * (j))
#define XB_TOP      3328
#define XB_TOPGEN   3392
#define XCD_BAR_WORDS 3456
#define XB_SPIN_CAP (1u << 18)

__device__ __forceinline__ unsigned xb_ld(unsigned* p)              { return __hip_atomic_load(p, __ATOMIC_RELAXED, __HIP_MEMORY_SCOPE_AGENT); }
__device__ __forceinline__ unsigned xb_add(unsigned* p, unsigned v) { return __hip_atomic_fetch_add(p, v, __ATOMIC_RELAXED, __HIP_MEMORY_SCOPE_AGENT); }
__device__ __forceinline__ unsigned xb_xcc_id() { return (unsigned)__builtin_amdgcn_s_getreg((3 << 11) | 20) & 0xFu; }
#define XB_SPIN(cond, bar) do { unsigned _sp = 0; while (cond) { __builtin_amdgcn_s_sleep(1); \
    if ((++_sp & 255u) == 0u) { if (xb_ld(&(bar)[XB_TMO])) break; if (_sp > XB_SPIN_CAP) { atomicAdd(&(bar)[XB_TMO], 1u); break; } } } } while (0)

struct XcdBarrier {
    unsigned* bar; unsigned x;
    volatile LAS unsigned* st;
};

__device__ __forceinline__ XcdBarrier xcd_barrier_post(unsigned* bar, volatile LAS unsigned* st) {
    XcdBarrier b; b.bar = bar; b.x = xb_xcc_id(); b.st = st;
    if (threadIdx.x == 0) (void)xb_add(&bar[XB_XCNT(b.x)], 1u);
    return b;
}
__device__ __forceinline__ void xcd_barrier_complete(unsigned* bar, unsigned x, unsigned& nloc, unsigned& nx) {
    const unsigned G = gridDim.x * gridDim.y * gridDim.z;
    unsigned sum, cnt, mine, sp = 0u;
    for (;;) {
        sum = 0u; cnt = 0u; mine = 0u;
#pragma unroll
        for (unsigned j = 0; j < 16; ++j) { const unsigned c = xb_ld(&bar[XB_XCNT(j)]); sum += c; cnt += (c > 0u) ? 1u : 0u; mine = (j == x) ? c : mine; }
        if (sum == G) break;
        __builtin_amdgcn_s_sleep(1);
        if ((++sp & 255u) == 0u) { if (xb_ld(&bar[XB_TMO])) break; if (sp > XB_SPIN_CAP) { atomicAdd(&bar[XB_TMO], 1u); break; } }
    }
    nloc = mine > 0u ? mine : 1u; nx = cnt > 0u ? cnt : 1u;
}

__device__ __forceinline__ void xcd_barrier(const XcdBarrier& b) {
    asm volatile("s_waitcnt vmcnt(0)" ::: "memory");
    __syncthreads();
    if (threadIdx.x == 0) {
        unsigned* bar = b.bar;
        __builtin_amdgcn_s_waitcnt(0);
        unsigned nloc = b.st[0], nx = b.st[1];
        if (nloc == 0u) { xcd_barrier_complete(bar, b.x, nloc, nx); b.st[0] = nloc; b.st[1] = nx; }
        const unsigned old = xb_add(&bar[XB_XSUB(b.x)], 1u);
        const unsigned gen = old / nloc;
        if (old + 1u == (gen + 1u) * nloc) {
            __builtin_amdgcn_fence(__ATOMIC_RELEASE, "agent");
            asm volatile("s_waitcnt vmcnt(0)" ::: "memory");
            const unsigned og = xb_add(&bar[XB_TOP], 1u);
            const unsigned tg = og / nx;
            if (og + 1u == (tg + 1u) * nx) xb_add(&bar[XB_TOPGEN], 1u);
            else XB_SPIN(xb_ld(&bar[XB_TOPGEN]) == tg, bar);
            __builtin_amdgcn_fence(__ATOMIC_ACQUIRE, "agent");
            xb_add(&bar[XB_XGEN(b.x)], 1u);
            asm volatile("s_waitcnt vmcnt(0)" ::: "memory");
        } else {
            XB_SPIN(xb_ld(&bar[XB_XGEN(b.x)]) == gen, bar);
            __builtin_amdgcn_fence(__ATOMIC_ACQUIRE, "agent");
            asm volatile("s_waitcnt vmcnt(0)" ::: "memory");
        }
    }
    __syncthreads();
}
#define LDS_WAIT() asm volatile("s_waitcnt lgkmcnt(0)" ::: "memory")
struct Frame {
    LAS unsigned char* lds;
    volatile LAS unsigned* MISC;
    gu32* ctl;
    int tid, lane, wave, G, bid;
    unsigned char* ws;
};
struct Args { const float* in[20]; float* out; unsigned char* ws; int ph_lo, ph_hi; };
#define IN_X(A) ((A).in[0])
#define IN_MEM(A) ((A).in[1])
#define IN_WIN(A) ((A).in[2])
#define IN_BMERGE(A) ((A).in[3])
#define IN_WA2(A) ((A).in[4])
#define IN_BA(A) ((A).in[5])
#define IN_NORMG(A) ((A).in[6])
#define IN_PEK(A) ((A).in[7])
#define IN_PEV(A) ((A).in[8])
#define IN_WK1(A) ((A).in[9])
#define IN_WK2(A) ((A).in[10])
#define IN_WV1(A) ((A).in[11])
#define IN_WV2(A) ((A).in[12])
#define IN_WKV(A) ((A).in[13])
#define IN_WOUT(A) ((A).in[17])
#define IN_LNG(A) ((A).in[18])
#define IN_LNB(A) ((A).in[19])
#define WSB(off) ((bf16*)(F.ws + (off)))
#define WSF(off) ((float*)(F.ws + (off)))

DI int wq_next(Frame& F, int cw) {
    __syncthreads();
    if (F.tid == 0) F.MISC[0] = __hip_atomic_fetch_add(F.ctl + cw, 1u, RLX_AGENT);
    __syncthreads();
    return (int)F.MISC[0];
}

template <class Map> DI void transpose_item(const float* W, int K, int Nsrc, bf16* WT, LAS float* scr, int kb, int nb, int lane, Map map) {
    const int k0 = 64 * kb, n0 = 32 * nb;
    const int ns = map(n0 + (lane & 31));
#pragma unroll 8
    for (int i = 0; i < 32; ++i) { const int kk = 2 * i + (lane >> 5); scr[kk * 33 + (lane & 31)] = ns >= 0 ? W[(size_t)(k0 + kk) * Nsrc + ns] : 0.f; }
    LDS_WAIT(); asm volatile("" ::: "memory");
    const int c = lane & 7;
#pragma unroll
    for (int j = 0; j < 4; ++j) { const int n = (lane >> 3) + 8 * j; const LAS float* s = scr + (8 * c) * 33 + n;
        u32x4 o; o.x = cvtpk(s[0 * 33], s[1 * 33]); o.y = cvtpk(s[2 * 33], s[3 * 33]); o.z = cvtpk(s[4 * 33], s[5 * 33]); o.w = cvtpk(s[6 * 33], s[7 * 33]);
        *(GAS u32x4*)(WT + (size_t)(n0 + n) * K + k0 + 8 * c) = o; }
    LDS_WAIT(); asm volatile("" ::: "memory");
}
struct IdMap { DI int operator()(int n) const { return n; } };
struct WinMap { DI int operator()(int n) const { return win_src_col(n); } };

DI void cvt_rows_bf16(const float* src, bf16* dst, size_t n8, size_t g0, size_t gstride) {
    for (size_t i = g0; i < n8; i += gstride) { const f32x4 a = ((const f32x4*)src)[2 * i], b = ((const f32x4*)src)[2 * i + 1];
        u32x4 o; o.x = cvtpk(a[0], a[1]); o.y = cvtpk(a[2], a[3]); o.z = cvtpk(b[0], b[1]); o.w = cvtpk(b[2], b[3]); ((u32x4*)dst)[i] = o; }
}

DI void p0_prologue(Frame& F, const Args& A) {
    LAS float* scr = (LAS float*)(F.lds + F.wave * 16384);
    const int gw = F.bid * NWAVES + F.wave, NGW = F.G * NWAVES;
    constexpr int I_WIN = 64 * (NP / 32), I_KV = 64 * 128, I_BR = 32 * 128, I_OUT = 64 * 128, I_W1 = 64 * 4, I_W2 = 2 * 4;
    constexpr int NITEMS = I_WIN + I_KV + 3 * I_BR + I_OUT + 2 * I_W1 + 2 * I_W2;
    for (int it = gw; it < NITEMS; it += NGW) {
        int r = it;
        if (r < I_WIN) { transpose_item(IN_WIN(A), 4096, D_IN, WSB(WS_WINT), scr, r / (NP / 32), r % (NP / 32), F.lane, WinMap()); continue; } r -= I_WIN;
        if (r < I_KV) { transpose_item(IN_WKV(A), 4096, 4096, WSB(WS_WKVT), scr, r / 128, r % 128, F.lane, IdMap()); continue; } r -= I_KV;
        if (r < 3 * I_BR) { const int br = r / I_BR, q = r % I_BR; transpose_item(br == 0 ? A.in[14] : (br == 1 ? A.in[15] : A.in[16]), 2048, 4096, WSB(WS_WBRT) + (size_t)br * 4096 * 2048, scr, q / 128, q % 128, F.lane, IdMap()); continue; } r -= 3 * I_BR;
        if (r < I_OUT) { transpose_item(IN_WOUT(A), 4096, 4096, WSB(WS_WOUTT), scr, r / 128, r % 128, F.lane, IdMap()); continue; } r -= I_OUT;
        if (r < 2 * I_W1) { const int kv = r / I_W1, q = r % I_W1; transpose_item(kv ? IN_WV1(A) : IN_WK1(A), 4096, 128, WSB(WS_W1T) + (size_t)kv * 128 * 4096, scr, q / 4, q % 4, F.lane, IdMap()); continue; } r -= 2 * I_W1;
        { const int kv = r / I_W2, q = r % I_W2; transpose_item(kv ? IN_WV2(A) : IN_WK2(A), 128, 128, WSB(WS_W2T) + (size_t)kv * 128 * 128, scr, q / 4, q % 4, F.lane, IdMap()); }
    }
    const size_t gt = (size_t)F.bid * 512 + F.tid, GT = (size_t)F.G * 512;
    cvt_rows_bf16(IN_X(A), WSB(WS_XB), (size_t)M * DM / 8, gt, GT);
    cvt_rows_bf16(IN_MEM(A), WSB(WS_MEMB), (size_t)512 * DM / 8, gt, GT);
    for (int o = gw; o < 256; o += NGW) { const int kv = o >> 7, j = o & 127; const float* pe = kv ? IN_PEV(A) : IN_PEK(A); const float* w1 = kv ? IN_WV1(A) : IN_WK1(A);
        float s = 0.f; for (int k = F.lane; k < 4096; k += 64) s += pe[k] * w1[(size_t)k * 128 + j];
        s = wave_sum(s); if (F.lane == 0) WSF(WS_C1)[o] = s; }
}
DI void mem_attn_item(Frame& F, int item) {
    const int tile = item & 63, head = (item >> 6) & 3, b = item >> 8;
    int tid = F.tid; asm volatile("" : "+v"(tid)); const int lane = tid & 63, w = __builtin_amdgcn_readfirstlane(tid >> 6); const int i = lane & 15, g = lane >> 4;
    const int tok = b * SEQ + tile * 128 + 16 * w + i;
    LAS char* KL = (LAS char*)F.lds;
    LAS char* VL = (LAS char*)F.lds + 36864;
    const bf16* qrow = WSB(WS_H) + (size_t)tok * NP + H_MQ + head * 512;
    bf16x8 qf[16];
#pragma unroll
    for (int s = 0; s < 16; ++s) qf[s] = *(const bf16x8*)(qrow + 32 * s + 8 * g);
    f32x4 sacc[16];
#pragma unroll
    for (int kt = 0; kt < 16; ++kt) sacc[kt] = (f32x4){0.f, 0.f, 0.f, 0.f};
    const char* kbase = (const char*)(WSB(WS_KVMEM) + (size_t)(b * 256) * 4096 + head * 512);
#pragma unroll
    for (int dc = 0; dc < 8; ++dc) {
        __syncthreads();
        g2l_tile<256, 8>(KL, 144, kbase + dc * 128, 8192, tid);
        __syncthreads();
#pragma unroll
        for (int s2 = 0; s2 < 2; ++s2)
#pragma unroll
            for (int kt = 0; kt < 16; ++kt) { const bf16x8 a = *(const LAS bf16x8*)(KL + (16 * kt + i) * 144 + (s2 * 32 + 8 * g) * 2); sacc[kt] = mfma16(a, qf[dc * 2 + s2], sacc[kt]); }
    }
    const float scale = 0.04419417382415922f;
    float mx = NEG;
#pragma unroll
    for (int kt = 0; kt < 16; ++kt)
#pragma unroll
        for (int r = 0; r < 4; ++r) mx = fmaxf(mx, sacc[kt][r]);
    mx = fmaxf(mx, __shfl_xor(mx, 16)); mx = fmaxf(mx, __shfl_xor(mx, 32));
    float sum = 0.f;
#pragma unroll
    for (int kt = 0; kt < 16; ++kt)
#pragma unroll
        for (int r = 0; r < 4; ++r) { const float p = __expf((sacc[kt][r] - mx) * scale); sacc[kt][r] = p; sum += p; }
    sum += __shfl_xor(sum, 16); sum += __shfl_xor(sum, 32);
    const float inv = 1.f / sum;
    bf16x8 pf[8];
#pragma unroll
    for (int s = 0; s < 8; ++s) pf[s] = pack2(sacc[2 * s], sacc[2 * s + 1]);
    const char* vbase = (const char*)(WSB(WS_KVMEM) + (size_t)(b * 256) * 4096 + 2048 + head * 512);
    const bf16* zrow = WSB(WS_H) + (size_t)tok * NP + H_MZ + head * 512;
    bf16* orow = WSB(WS_GATED) + (size_t)2 * M * 2048 + (size_t)tok * 2048 + head * 512;
#pragma unroll 1
    for (int dcv = 0; dcv < 4; ++dcv) {
        __syncthreads();
        g2l_tile<256, 16>(VL, 272, vbase + dcv * 256, 8192, tid);
        __syncthreads();
        f32x4 oacc[8];
#pragma unroll
        for (int dt = 0; dt < 8; ++dt) oacc[dt] = (f32x4){0.f, 0.f, 0.f, 0.f};
#pragma unroll
        for (int s = 0; s < 8; ++s)
#pragma unroll
            for (int dt = 0; dt < 8; ++dt) { const bf16x8 a = tr_frag(VL, 272, 16 * dt, 32 * s + 4 * g, 32 * s + 16 + 4 * g, lane); oacc[dt] = mfma16(a, pf[s], oacc[dt]); }
#pragma unroll
        for (int dt = 0; dt < 8; ++dt) { const int d0 = dcv * 128 + 16 * dt + 4 * g;
            const u32x2 z = *(const u32x2*)(zrow + d0);
            const float o0 = oacc[dt][0] * inv * siluf_(bflo(z.x)), o1 = oacc[dt][1] * inv * siluf_(bfhi(z.x)), o2 = oacc[dt][2] * inv * siluf_(bflo(z.y)), o3 = oacc[dt][3] * inv * siluf_(bfhi(z.y));
            u32x2 o; o.x = cvtpk(o0, o1); o.y = cvtpk(o2, o3); *(u32x2*)(orow + d0) = o; }
    }
}

DI void compress_item(Frame& F, int item) {
    const int ntile = item & 3, g = (item >> 2) & 3, b = (item >> 4) & 1, kv = item >> 5;
    int tid = F.tid; asm volatile("" : "+v"(tid)); const int lane = tid & 63, w = __builtin_amdgcn_readfirstlane(tid >> 6); const int i = lane & 15, gq = lane >> 4; (void)tid;
    const int n = ntile * 128 + 16 * w + i, nn = n < 510 ? n : 510;
    const bf16* xbase = WSB(WS_H) + (size_t)(b * SEQ + 16 * nn) * NP + (kv ? H_NVC : H_NKC) + g * 128;
    const bf16* w1t = WSB(WS_W1T) + (size_t)kv * 128 * 4096;
    const bf16* w2t = WSB(WS_W2T) + (size_t)kv * 128 * 128;
    f32x4 acc[8];
#pragma unroll
    for (int jt = 0; jt < 8; ++jt) acc[jt] = *(const f32x4*)(WSF(WS_C1) + kv * 128 + 16 * jt + 4 * gq);
#pragma unroll 2
    for (int s = 0; s < 128; ++s) {
        const bf16x8 bx = *(const bf16x8*)(xbase + (size_t)(s >> 2) * NP + (s & 3) * 32 + 8 * gq);
#pragma unroll
        for (int jt = 0; jt < 8; ++jt) { const bf16x8 aw = *(const bf16x8*)(w1t + (size_t)(16 * jt + i) * 4096 + 32 * s + 8 * gq); acc[jt] = mfma16(aw, bx, acc[jt]); }
    }
#pragma unroll
    for (int jt = 0; jt < 8; ++jt)
#pragma unroll
        for (int r = 0; r < 4; ++r) acc[jt][r] = siluf_(acc[jt][r]);
    bf16x8 hf[4];
#pragma unroll
    for (int s = 0; s < 4; ++s) hf[s] = pack2(acc[2 * s], acc[2 * s + 1]);
    bf16* orow = WSB(WS_CMP) + ((size_t)((kv * 2 + b) * 4 + g) * 512 + n) * 128;
#pragma unroll
    for (int jt = 0; jt < 8; ++jt) {
        f32x4 o = (f32x4){0.f, 0.f, 0.f, 0.f};
#pragma unroll
        for (int s = 0; s < 4; ++s) { const bf16* wr_ = w2t + (size_t)(16 * jt + i) * 128 + 32 * s + 4 * gq;
            const s16x4 lo = *(const s16x4*)wr_, hi = *(const s16x4*)(wr_ + 16);
            const bf16x8 aw = __builtin_shufflevector(lo, hi, 0, 1, 2, 3, 4, 5, 6, 7);
            o = mfma16(aw, hf[s], o); }
        u32x2 ov; if (n <= 510) { ov.x = cvtpk(o[0], o[1]); ov.y = cvtpk(o[2], o[3]); } else { ov.x = 0u; ov.y = 0u; }
        *(u32x2*)(orow + 16 * jt + 4 * gq) = ov;
    }
}
DI void gla_prep_item(Frame& F, const Args& A, int item) {
    const int n = item & 127, h = (item >> 7) & 3, b = item >> 9;
    const int tok0 = b * SEQ + 64 * n;
    int tid = F.tid; asm volatile("" : "+v"(tid)); const int lane = tid & 63, w = __builtin_amdgcn_readfirstlane(tid >> 6); const int i = lane & 15, g = lane >> 4;
    LAS float* LA = (LAS float*)F.lds;
    LAS char* VL = (LAS char*)F.lds;
    LAS char* QL = (LAS char*)F.lds + 66560;
    LAS char* KL = (LAS char*)F.lds + 100352;
    LAS float* GA = (LAS float*)(F.lds + 134144);
    LAS u32x4* ATT = (LAS u32x4*)(F.lds + 138240);
    if (tid < 128) { const int c = tid >> 1, hf = tid & 1; const u32x4 v = *(const u32x4*)(WSB(WS_H) + (size_t)(tok0 + c) * NP + H_SM + 8 * hf);
        LAS float* gp = GA + c * 16 + 8 * hf; gp[0] = bflo(v.x); gp[1] = bfhi(v.x); gp[2] = bflo(v.y); gp[3] = bfhi(v.y); gp[4] = bflo(v.z); gp[5] = bfhi(v.z); gp[6] = bflo(v.w); gp[7] = bfhi(v.w); }
    __syncthreads();
    { const int d = tid & 255, hf = tid >> 8; float wa[16];
#pragma unroll
      for (int j = 0; j < 16; ++j) wa[j] = IN_WA2(A)[j * 1024 + h * 256 + d];
      const float ba = IN_BA(A)[h * 256 + d]; float run = 0.f;
      for (int cc = 0; cc < 32; ++cc) { const int c = hf * 32 + cc; float lg = ba;
#pragma unroll
          for (int j = 0; j < 16; ++j) lg += GA[c * 16 + j] * wa[j];
          const float ls = -(fmaxf(-lg, 0.f) + __logf(1.f + __expf(-fabsf(lg))));
          run += ls * 0.0625f; LA[c * 256 + d] = run; } }
    __syncthreads();
#pragma unroll 1
    for (int it = 0; it < 4; ++it) { const int u = tid + 512 * it, c = u >> 5, d0 = (u & 31) * 8;
        const u32x4 qv = *(const u32x4*)(WSB(WS_H) + (size_t)(tok0 + c) * NP + H_GQ + h * 256 + d0);
        const u32x4 kv = *(const u32x4*)(WSB(WS_H) + (size_t)(tok0 + c) * NP + H_GK + h * 256 + d0);
        const unsigned qw[4] = {qv.x, qv.y, qv.z, qv.w}, kw[4] = {kv.x, kv.y, kv.z, kv.w};
        float qd[8], kd[8], ke[8];
#pragma unroll
        for (int e = 0; e < 8; ++e) { const int d = d0 + e; const float o31 = LA[31 * 256 + d], bl = LA[63 * 256 + d] + o31, bc = LA[c * 256 + d] + (c >= 32 ? o31 : 0.f);
            const float qq = (e & 1) ? bfhi(qw[e >> 1]) : bflo(qw[e >> 1]), kk = (e & 1) ? bfhi(kw[e >> 1]) : bflo(kw[e >> 1]);
            qd[e] = qq * 0.0625f * __expf(bc); kd[e] = kk * __expf(-bc); ke[e] = kk * __expf(bl - bc);
            if (c == 63) WSF(WS_GDEC)[(size_t)item * 256 + d] = __expf(bl); }
        u32x4 o; o.x = cvtpk(qd[0], qd[1]); o.y = cvtpk(qd[2], qd[3]); o.z = cvtpk(qd[4], qd[5]); o.w = cvtpk(qd[6], qd[7]); *(LAS u32x4*)(QL + c * 528 + d0 * 2) = o;
        o.x = cvtpk(kd[0], kd[1]); o.y = cvtpk(kd[2], kd[3]); o.z = cvtpk(kd[4], kd[5]); o.w = cvtpk(kd[6], kd[7]); *(LAS u32x4*)(KL + c * 528 + d0 * 2) = o;
        o.x = cvtpk(ke[0], ke[1]); o.y = cvtpk(ke[2], ke[3]); o.z = cvtpk(ke[4], ke[5]); o.w = cvtpk(ke[6], ke[7]); *(u32x4*)(WSB(WS_KEND) + (size_t)(tok0 + c) * 1024 + h * 256 + d0) = o; }
    __syncthreads();
#pragma unroll 1
    for (int it = 0; it < 4; ++it) { const int u = tid + 512 * it, c = u >> 5, pc = u & 31, g32 = pc >> 2, gg = pc & 3;
        const u32x2 lo = *(const LAS u32x2*)(QL + c * 528 + (32 * g32 + 4 * gg) * 2), hi = *(const LAS u32x2*)(QL + c * 528 + (32 * g32 + 16 + 4 * gg) * 2);
        u32x4 o; o.x = lo.x; o.y = lo.y; o.z = hi.x; o.w = hi.y; *(u32x4*)(WSB(WS_QD) + (size_t)(tok0 + c) * 1024 + h * 256 + 8 * pc) = o; }
    { const int ct = w & 3, jp = w >> 2; f32x4 a0 = (f32x4){0.f, 0.f, 0.f, 0.f}, a1 = a0;
#pragma unroll
      for (int s = 0; s < 8; ++s) { const bf16x8 bq = *(const LAS bf16x8*)(QL + (16 * ct + i) * 528 + (32 * s + 8 * g) * 2);
          const bf16x8 k0 = *(const LAS bf16x8*)(KL + (32 * jp + i) * 528 + (32 * s + 8 * g) * 2), k1 = *(const LAS bf16x8*)(KL + (32 * jp + 16 + i) * 528 + (32 * s + 8 * g) * 2);
          a0 = mfma16(k0, bq, a0); a1 = mfma16(k1, bq, a1); }
      const int c = 16 * ct + i;
#pragma unroll
      for (int r = 0; r < 4; ++r) { if (32 * jp + 4 * g + r > c) a0[r] = 0.f; if (32 * jp + 16 + 4 * g + r > c) a1[r] = 0.f; }
      ATT[(ct * 2 + jp) * 64 + lane] = __builtin_bit_cast(u32x4, pack2(a0, a1)); }
    __syncthreads();
    g2l_tile<64, 64>(VL, 1040, (const char*)(WSB(WS_H) + (size_t)tok0 * NP + H_GV + h * 512), (size_t)NP * 2, tid);
    __syncthreads();
    { f32x4 acc[4][4];
#pragma unroll
      for (int et = 0; et < 4; ++et)
#pragma unroll
          for (int ct = 0; ct < 4; ++ct) acc[et][ct] = (f32x4){0.f, 0.f, 0.f, 0.f};
#pragma unroll
      for (int s = 0; s < 2; ++s) { bf16x8 bfr[4];
#pragma unroll
          for (int ct = 0; ct < 4; ++ct) bfr[ct] = __builtin_bit_cast(bf16x8, ATT[(ct * 2 + s) * 64 + lane]);
#pragma unroll
          for (int et = 0; et < 4; ++et) { const bf16x8 a = tr_frag(VL, 1040, 64 * w + 16 * et, 32 * s + 4 * g, 32 * s + 16 + 4 * g, lane);
#pragma unroll
              for (int ct = 0; ct < 4; ++ct) acc[et][ct] = mfma16(a, bfr[ct], acc[et][ct]); } }
#pragma unroll
      for (int et = 0; et < 4; ++et)
#pragma unroll
          for (int ct = 0; ct < 4; ++ct) *(f32x4*)(WSF(WS_GO) + (size_t)(tok0 + 16 * ct + i) * 2048 + h * 512 + 64 * w + 16 * et + 4 * g) = acc[et][ct]; }
    __syncthreads();
}

DI void gla_scan_item(Frame& F, int item) {
    const int es = item & 3, h = (item >> 2) & 3, b = item >> 4;
    int tid = F.tid; asm volatile("" : "+v"(tid)); const int lane = tid & 63, w = __builtin_amdgcn_readfirstlane(tid >> 6); const int i = lane & 15, g = lane >> 4;
    LAS char* QL = (LAS char*)F.lds;
    LAS char* KL = (LAS char*)F.lds + 33792;
    LAS char* VL = (LAS char*)F.lds + 67584;
    LAS float* GD = (LAS float*)(F.lds + 84992);
    f32x4 S[16];
#pragma unroll
    for (int dt = 0; dt < 16; ++dt) S[dt] = (f32x4){0.f, 0.f, 0.f, 0.f};
    u32x4 pq[4], pk[4], pv[2], pg[1];
    const size_t tokb = (size_t)b * SEQ;
    const int ecol = h * 512 + es * 128;
    pf_load<64, 32>(pq, (const char*)(WSB(WS_QD) + tokb * 1024 + h * 256), 2048, tid);
    pf_load<64, 32>(pk, (const char*)(WSB(WS_KEND) + tokb * 1024 + h * 256), 2048, tid);
    pf_load<64, 16>(pv, (const char*)(WSB(WS_H) + tokb * NP + H_GV + ecol), (size_t)NP * 2, tid);
    pf_load<1, 64>(pg, (const char*)(WSF(WS_GDEC) + (size_t)((b * 4 + h) * 128) * 256), 0, tid);
#pragma unroll 1
    for (int n = 0; n < 128; ++n) {
        __syncthreads();
        pf_store<64, 32>(pq, QL, 528, tid); pf_store<64, 32>(pk, KL, 528, tid); pf_store<64, 16>(pv, VL, 272, tid); pf_store<1, 64>(pg, (LAS char*)GD, 0, tid);
        __syncthreads();
        const size_t tok0 = tokb + 64 * n;
        if (n + 1 < 128) { const size_t t1 = tok0 + 64;
            pf_load<64, 32>(pq, (const char*)(WSB(WS_QD) + t1 * 1024 + h * 256), 2048, tid);
            pf_load<64, 32>(pk, (const char*)(WSB(WS_KEND) + t1 * 1024 + h * 256), 2048, tid);
            pf_load<64, 16>(pv, (const char*)(WSB(WS_H) + t1 * NP + H_GV + ecol), (size_t)NP * 2, tid);
            pf_load<1, 64>(pg, (const char*)(WSF(WS_GDEC) + (size_t)((b * 4 + h) * 128 + n + 1) * 256), 0, tid); }
        f32x4 oa[4];
#pragma unroll
        for (int ct = 0; ct < 4; ++ct) oa[ct] = (f32x4){0.f, 0.f, 0.f, 0.f};
#pragma unroll
        for (int s = 0; s < 8; ++s) { const bf16x8 a = pack2(S[2 * s], S[2 * s + 1]);
#pragma unroll
            for (int ct = 0; ct < 4; ++ct) { const bf16x8 bq = *(const LAS bf16x8*)(QL + (16 * ct + i) * 528 + (32 * s + 8 * g) * 2); oa[ct] = mfma16(a, bq, oa[ct]); } }
#pragma unroll
        for (int ct = 0; ct < 4; ++ct) { float* op = WSF(WS_GO) + (tok0 + 16 * ct + i) * 2048 + ecol + 16 * w + 4 * g; const f32x4 o = *(const f32x4*)op; *(f32x4*)op = o + oa[ct]; }
#pragma unroll
        for (int dt = 0; dt < 16; ++dt) { const f32x4 gd = *(const LAS f32x4*)(GD + 16 * dt + 4 * g); S[dt] = S[dt] * gd; }
#pragma unroll
        for (int s = 0; s < 2; ++s) { const bf16x8 bv = tr_frag(VL, 272, 16 * w, 32 * s + 8 * g, 32 * s + 8 * g + 4, lane);
#pragma unroll
            for (int dt = 0; dt < 16; ++dt) { const bf16x8 a = tr_frag(KL, 528, 16 * dt, 32 * s + 8 * g, 32 * s + 8 * g + 4, lane); S[dt] = mfma16(a, bv, S[dt]); } }
    }
    __syncthreads();
}

DI void gla_finalize(Frame& F, const Args& A) {
    const int gw = F.bid * NWAVES + F.wave, NGW = F.G * NWAVES, lane = F.lane;
    const f32x4 g0 = *(const f32x4*)(IN_NORMG(A) + 8 * lane), g1 = *(const f32x4*)(IN_NORMG(A) + 8 * lane + 4);
    for (int idx = gw; idx < M * 4; idx += NGW) { const int tok = idx >> 2, h = idx & 3;
        const float* op = WSF(WS_GO) + (size_t)tok * 2048 + h * 512 + 8 * lane;
        const f32x4 a = *(const f32x4*)op, c = *(const f32x4*)(op + 4);
        float ss = a[0] * a[0] + a[1] * a[1] + a[2] * a[2] + a[3] * a[3] + c[0] * c[0] + c[1] * c[1] + c[2] * c[2] + c[3] * c[3];
        ss = wave_sum(ss);
        const float rs = rsqrtf(ss * (1.f / 512.f) + RMS_EPS);
        const u32x4 z = *(const u32x4*)(WSB(WS_H) + (size_t)tok * NP + H_GZ + h * 512 + 8 * lane);
        u32x4 o;
        o.x = cvtpk(a[0] * rs * g0[0] * siluf_(bflo(z.x)), a[1] * rs * g0[1] * siluf_(bfhi(z.x)));
        o.y = cvtpk(a[2] * rs * g0[2] * siluf_(bflo(z.y)), a[3] * rs * g0[3] * siluf_(bfhi(z.y)));
        o.z = cvtpk(c[0] * rs * g1[0] * siluf_(bflo(z.z)), c[1] * rs * g1[1] * siluf_(bfhi(z.z)));
        o.w = cvtpk(c[2] * rs * g1[2] * siluf_(bflo(z.w)), c[3] * rs * g1[3] * siluf_(bfhi(z.w)));
        *(u32x4*)(WSB(WS_GATED) + (size_t)tok * 2048 + h * 512 + 8 * lane) = o; }
}
DI void qk_tile(f32x4 (&sacc)[4], const LAS char* KL, const bf16x8 (&qf)[4], int i, int grp) {
#pragma unroll
    for (int kt = 0; kt < 4; ++kt) { f32x4 a = (f32x4){0.f, 0.f, 0.f, 0.f};
#pragma unroll
        for (int s = 0; s < 4; ++s) { const bf16x8 ak = *(const LAS bf16x8*)(KL + (16 * kt + i) * 272 + (32 * s + 8 * grp) * 2); a = mfma16(ak, qf[s], a); }
        sacc[kt] = a; }
}
DI void pv_tile(f32x4 (&oacc)[8], const LAS char* VL, const bf16x8 (&pf)[2], int lane, int grp) {
#pragma unroll
    for (int s2 = 0; s2 < 2; ++s2)
#pragma unroll
        for (int dt = 0; dt < 8; ++dt) { const bf16x8 a = tr_frag(VL, 272, 16 * dt, 32 * s2 + 4 * grp, 32 * s2 + 16 + 4 * grp, lane); oacc[dt] = mfma16(a, pf[s2], oacc[dt]); }
}
DI void online_tile(f32x4 (&sacc)[4], unsigned vmask, float& m, float& l, f32x4 (&oacc)[8], const LAS char* VL, int lane, int grp) {
    float tm = NEG;
#pragma unroll
    for (int kt = 0; kt < 4; ++kt)
#pragma unroll
        for (int r = 0; r < 4; ++r) tm = fmaxf(tm, sacc[kt][r]);
    tm = fmaxf(tm, __shfl_xor(tm, 16)); tm = fmaxf(tm, __shfl_xor(tm, 32));
    const float mn = fmaxf(m, tm), alpha = __expf(m - mn);
    float ps = 0.f;
#pragma unroll
    for (int kt = 0; kt < 4; ++kt)
#pragma unroll
        for (int r = 0; r < 4; ++r) { const float p = ((vmask >> (4 * kt + r)) & 1u) ? __expf(sacc[kt][r] - mn) : 0.f; sacc[kt][r] = p; ps += p; }
    l = l * alpha + ps; m = mn;
#pragma unroll
    for (int dt = 0; dt < 8; ++dt) oacc[dt] = oacc[dt] * alpha;
    bf16x8 pf[2]; pf[0] = pack2(sacc[0], sacc[1]); pf[1] = pack2(sacc[2], sacc[3]);
    pv_tile(oacc, VL, pf, lane, grp);
}

DI void nsa_attend_item(Frame& F, int item) {
    const int qt = 255 - (item & 255), g = (item >> 8) & 3, b = item >> 10;
    int tid = F.tid; asm volatile("" : "+v"(tid)); const int lane = tid & 63, w = __builtin_amdgcn_readfirstlane(tid >> 6); const int i = lane & 15, grp = lane >> 4, ql = i >> 2, r4 = i & 3;
    const int t0 = 32 * qt, qi = 4 * w + ql, t = t0 + qi, head = 4 * g + r4;
    const size_t tok = (size_t)b * SEQ + t;
    const float slope = exp2f(-0.5f * (float)(head + 1));
    const float scale = 0.08838834764831845f;
    LAS char* KL = (LAS char*)F.lds;
    LAS char* VL = (LAS char*)F.lds + 17408;
    LAS float* IMPA = (LAS float*)(F.lds + 34816);
    LAS float* IMPB = (LAS float*)(F.lds + 51200);
    LAS unsigned* SELM = (LAS unsigned*)(F.lds + 67584);
    bf16x8 qf[4];
    { const bf16* qrow = WSB(WS_H) + tok * NP + H_NQ + head * 128;
#pragma unroll
      for (int s = 0; s < 4; ++s) qf[s] = *(const bf16x8*)(qrow + 32 * s + 8 * grp); }
    float gate[3];
#pragma unroll
    for (int br = 0; br < 3; ++br) gate[br] = sigmoidf_(bf2f(WSB(WS_H)[tok * NP + H_SM + 16 + head * 3 + br]));
    f32x4 comb[8], oacc[8], sacc[4];
#pragma unroll
    for (int dt = 0; dt < 8; ++dt) comb[dt] = (f32x4){0.f, 0.f, 0.f, 0.f};

    const int cnt_t = t >= 31 ? ((t - 31) >> 4) + 1 : 0;
    const int ntile = (2 * qt + 1 + 63) >> 6;
    const char* kcb = (const char*)(WSB(WS_CMP) + (size_t)((0 * 2 + b) * 4 + g) * 512 * 128);
    const char* vcb = (const char*)(WSB(WS_CMP) + (size_t)((1 * 2 + b) * 4 + g) * 512 * 128);
    __syncthreads();
    for (int u = tid; u < 8192; u += 512) IMPA[u] = 0.f;
    float m = NEG, l = 0.f;
#pragma unroll 1
    for (int T = 0; T < ntile; ++T) {
        __syncthreads();
        g2l_tile<64, 16>(KL, 272, kcb + (size_t)T * 64 * 256, 256, tid);
        __syncthreads();
        qk_tile(sacc, KL, qf, i, grp);
        float tm = NEG;
#pragma unroll
        for (int kt = 0; kt < 4; ++kt)
#pragma unroll
            for (int r = 0; r < 4; ++r) { const int n = 64 * T + 16 * kt + 4 * grp + r; const float s = n < cnt_t ? sacc[kt][r] * scale - slope * (float)(t - (16 * n + 31)) : NEG; sacc[kt][r] = s; tm = fmaxf(tm, s); }
        tm = fmaxf(tm, __shfl_xor(tm, 16)); tm = fmaxf(tm, __shfl_xor(tm, 32));
        const float mn = fmaxf(m, tm); float ps = 0.f;
#pragma unroll
        for (int kt = 0; kt < 4; ++kt)
#pragma unroll
            for (int r = 0; r < 4; ++r) { const int n = 64 * T + 16 * kt + 4 * grp + r; ps += n < cnt_t ? __expf(sacc[kt][r] - mn) : 0.f; }
        l = l * __expf(m - mn) + ps; m = mn;
    }
    l += __shfl_xor(l, 16); l += __shfl_xor(l, 32);
    const float inv = (cnt_t > 0 && l > 0.f) ? 1.f / l : 0.f;
#pragma unroll
    for (int dt = 0; dt < 8; ++dt) oacc[dt] = (f32x4){0.f, 0.f, 0.f, 0.f};
#pragma unroll 1
    for (int T = 0; T < ntile; ++T) {
        __syncthreads();
        g2l_tile<64, 16>(KL, 272, kcb + (size_t)T * 64 * 256, 256, tid);
        g2l_tile<64, 16>(VL, 272, vcb + (size_t)T * 64 * 256, 256, tid);
        __syncthreads();
        qk_tile(sacc, KL, qf, i, grp);
#pragma unroll
        for (int kt = 0; kt < 4; ++kt) {
#pragma unroll
            for (int r = 0; r < 4; ++r) { const int n = 64 * T + 16 * kt + 4 * grp + r; sacc[kt][r] = n < cnt_t ? __expf(sacc[kt][r] * scale - slope * (float)(t - (16 * n + 31)) - m) * inv : 0.f; }
            f32x4 ps = sacc[kt];
#pragma unroll
            for (int r = 0; r < 4; ++r) { ps[r] += __shfl_xor(ps[r], 1); ps[r] += __shfl_xor(ps[r], 2); }
            const int j = 16 * T + 4 * kt + grp;
            if (r4 == 0) { IMPA[qi * 128 + j] = (ps[0] + ps[1]) + (ps[2] + ps[3]); if (j + 1 < 128) IMPB[qi * 128 + j + 1] = ps[3]; }
        }
        bf16x8 pf[2]; pf[0] = pack2(sacc[0], sacc[1]); pf[1] = pack2(sacc[2], sacc[3]);
        pv_tile(oacc, VL, pf, lane, grp);
    }
#pragma unroll
    for (int dt = 0; dt < 8; ++dt) comb[dt] = comb[dt] + oacc[dt] * gate[0];
    __syncthreads();

    const int cur = t0 >> 6;
#pragma unroll 1
    for (int qq = 0; qq < 4; ++qq) { const int q = 4 * w + qq, tq = t0 + q; const int j0 = lane, j1 = lane + 64;
        float v0 = (j0 == 0 || j0 == cur || j0 == cur - 1) ? 1e4f : (j0 <= cur ? IMPA[q * 128 + j0] + IMPB[q * 128 + j0] : -1.f);
        float v1 = (j1 == cur || j1 == cur - 1) ? 1e4f : (j1 <= cur ? IMPA[q * 128 + j1] + IMPB[q * 128 + j1] : -1.f);
        (void)tq;
        unsigned mk0 = 0u, mk1 = 0u, mk2 = 0u, mk3 = 0u;
#pragma unroll 1
        for (int round = 0; round < 16; ++round) { float bv = v0; int bi = j0; if (v1 > v0) { bv = v1; bi = j1; }
#pragma unroll
            for (int off = 32; off >= 1; off >>= 1) { const float ov = __shfl_xor(bv, off); const int oi = __shfl_xor(bi, off); if (ov > bv || (ov == bv && oi < bi)) { bv = ov; bi = oi; } }
            if (bi == j0) v0 = -2.f; if (bi == j1) v1 = -2.f;
            const unsigned bit = 1u << (bi & 31); const int wd = bi >> 5;
            mk0 |= wd == 0 ? bit : 0u; mk1 |= wd == 1 ? bit : 0u; mk2 |= wd == 2 ? bit : 0u; mk3 |= wd == 3 ? bit : 0u; }
        if (lane == 0) { SELM[q * 4 + 0] = mk0; SELM[q * 4 + 1] = mk1; SELM[q * 4 + 2] = mk2; SELM[q * 4 + 3] = mk3; } }
    __syncthreads();
    unsigned u0 = 0u, u1 = 0u, u2 = 0u, u3 = 0u;
    for (int q = 0; q < 32; ++q) { u0 |= SELM[q * 4 + 0]; u1 |= SELM[q * 4 + 1]; u2 |= SELM[q * 4 + 2]; u3 |= SELM[q * 4 + 3]; }
    const unsigned mm0 = SELM[qi * 4 + 0], mm1 = SELM[qi * 4 + 1], mm2 = SELM[qi * 4 + 2], mm3 = SELM[qi * 4 + 3];
    u0 = __builtin_amdgcn_readfirstlane(u0 & (cur >= 31 ? 0xffffffffu : ((2u << cur) - 1u)));
    u1 = __builtin_amdgcn_readfirstlane(u1 & (cur >= 63 ? 0xffffffffu : (cur < 32 ? 0u : ((2u << (cur - 32)) - 1u))));
    u2 = __builtin_amdgcn_readfirstlane(u2 & (cur >= 95 ? 0xffffffffu : (cur < 64 ? 0u : ((2u << (cur - 64)) - 1u))));
    u3 = __builtin_amdgcn_readfirstlane(u3 & (cur >= 127 ? 0xffffffffu : (cur < 96 ? 0u : ((2u << (cur - 96)) - 1u))));

    m = NEG; l = 0.f;
#pragma unroll
    for (int dt = 0; dt < 8; ++dt) oacc[dt] = (f32x4){0.f, 0.f, 0.f, 0.f};
#pragma unroll 1
    for (;;) { int j; unsigned mw;
        if (u0) { j = __builtin_ctz(u0); u0 &= u0 - 1u; mw = mm0; } else if (u1) { j = 32 + __builtin_ctz(u1); u1 &= u1 - 1u; mw = mm1; }
        else if (u2) { j = 64 + __builtin_ctz(u2); u2 &= u2 - 1u; mw = mm2; } else if (u3) { j = 96 + __builtin_ctz(u3); u3 &= u3 - 1u; mw = mm3; } else break;
        {
            const char* kb = (const char*)(WSB(WS_H) + ((size_t)b * SEQ + 64 * j) * NP + H_NKS + g * 128);
            __syncthreads();
            g2l_tile<64, 16>(KL, 272, kb, (size_t)NP * 2, tid);
            g2l_tile<64, 16>(VL, 272, kb + (H_NVS - H_NKS) * 2, (size_t)NP * 2, tid);
            __syncthreads();
            qk_tile(sacc, KL, qf, i, grp);
            const bool sel = (mw >> (j & 31)) & 1u; unsigned vmask = 0u;
#pragma unroll
            for (int kt = 0; kt < 4; ++kt)
#pragma unroll
                for (int r = 0; r < 4; ++r) { const int pos = 64 * j + 16 * kt + 4 * grp + r; const bool ok = sel && pos <= t;
                    sacc[kt][r] = ok ? sacc[kt][r] * scale - slope * (float)(t - pos) : NEG; vmask |= ok ? (1u << (4 * kt + r)) : 0u; }
            online_tile(sacc, vmask, m, l, oacc, VL, lane, grp);
        } }
    l += __shfl_xor(l, 16); l += __shfl_xor(l, 32);
    { const float il = l > 0.f ? gate[1] / l : 0.f;
#pragma unroll
      for (int dt = 0; dt < 8; ++dt) comb[dt] = comb[dt] + oacc[dt] * il; }

    m = NEG; l = 0.f;
#pragma unroll
    for (int dt = 0; dt < 8; ++dt) oacc[dt] = (f32x4){0.f, 0.f, 0.f, 0.f};
    const int jlo = t0 >= 511 ? (t0 - 511) >> 6 : 0;
#pragma unroll 1
    for (int j = jlo; j <= cur; ++j) {
        const char* kb = (const char*)(WSB(WS_H) + ((size_t)b * SEQ + 64 * j) * NP + H_NKW + g * 128);
        __syncthreads();
        g2l_tile<64, 16>(KL, 272, kb, (size_t)NP * 2, tid);
        g2l_tile<64, 16>(VL, 272, kb + (H_NVW - H_NKW) * 2, (size_t)NP * 2, tid);
        __syncthreads();
        qk_tile(sacc, KL, qf, i, grp);
        unsigned vmask = 0u;
#pragma unroll
        for (int kt = 0; kt < 4; ++kt)
#pragma unroll
            for (int r = 0; r < 4; ++r) { const int pos = 64 * j + 16 * kt + 4 * grp + r; const int dist = t - pos; const bool ok = dist >= 0 && dist < 512;
                sacc[kt][r] = ok ? sacc[kt][r] * scale - slope * (float)dist : NEG; vmask |= ok ? (1u << (4 * kt + r)) : 0u; }
        online_tile(sacc, vmask, m, l, oacc, VL, lane, grp);
    }
    l += __shfl_xor(l, 16); l += __shfl_xor(l, 32);
    { const float il = l > 0.f ? gate[2] / l : 0.f;
#pragma unroll
      for (int dt = 0; dt < 8; ++dt) comb[dt] = comb[dt] + oacc[dt] * il; }

    { const bf16* zrow = WSB(WS_H) + tok * NP + H_NZ + head * 128; bf16* orow = WSB(WS_GATED) + (size_t)1 * M * 2048 + tok * 2048 + head * 128;
#pragma unroll
      for (int dt = 0; dt < 8; ++dt) { const int d0 = 16 * dt + 4 * grp; const u32x2 z = *(const u32x2*)(zrow + d0);
          u32x2 o; o.x = cvtpk(comb[dt][0] * siluf_(bflo(z.x)), comb[dt][1] * siluf_(bfhi(z.x))); o.y = cvtpk(comb[dt][2] * siluf_(bflo(z.y)), comb[dt][3] * siluf_(bfhi(z.y)));
          *(u32x2*)(orow + d0) = o; } }
    __syncthreads();
}
DI void ln_rows(Frame& F, const Args& A) {
    const int gw = F.bid * NWAVES + F.wave, NGW = F.G * NWAVES, lane = F.lane;
    for (int row = gw; row < M; row += NGW) {
        f32x4* rp = (f32x4*)(A.out + (size_t)row * DM) + lane;
        f32x4 v[16]; float s = 0.f;
#pragma unroll
        for (int j = 0; j < 16; ++j) { v[j] = rp[64 * j]; s += (v[j][0] + v[j][1]) + (v[j][2] + v[j][3]); }
        const float mean = wave_sum(s) * (1.f / DM); float q = 0.f;
#pragma unroll
        for (int j = 0; j < 16; ++j) { v[j] = v[j] - mean; q += (v[j][0] * v[j][0] + v[j][1] * v[j][1]) + (v[j][2] * v[j][2] + v[j][3] * v[j][3]); }
        const float rstd = rsqrtf(wave_sum(q) * (1.f / DM) + LN_EPS);
#pragma unroll
        for (int j = 0; j < 16; ++j) { const f32x4 gg = ((const f32x4*)IN_LNG(A))[lane + 64 * j], bb = ((const f32x4*)IN_LNB(A))[lane + 64 * j]; rp[64 * j] = v[j] * rstd * gg + bb; }
    }
}

constexpr int N_PHASES = 8;
__global__ void __launch_bounds__(NWAVES * 64, 2) mk_fwd(Args args) {
    extern __shared__ __attribute__((aligned(16))) unsigned char lds_raw[];
    Frame F;
    F.lds = (LAS unsigned char*)lds_raw;
    F.MISC = (volatile LAS unsigned*)(F.lds + MISC_OFF);
    F.tid = threadIdx.x; F.lane = F.tid & 63; F.wave = __builtin_amdgcn_readfirstlane(F.tid >> 6);
    F.G = gridDim.x; F.bid = blockIdx.x;
    F.ws = args.ws;
    F.ctl = (gu32*)(F.ws + WS_CTL);
    for (int u = F.tid; u < 64; u += NWAVES * 64) ((LAS unsigned*)(F.lds + MISC_OFF))[u] = 0u;
    __syncthreads();
    const int lo = args.ph_lo, hi = args.ph_hi;
    XcdBarrier bar; bar.bar = (unsigned*)(F.ctl + CW_BAR); bar.x = 0; bar.st = nullptr;
    if (hi - lo > 1) bar = xcd_barrier_post((unsigned*)(F.ctl + CW_BAR), F.MISC + 8);
#ifndef MK_PHASE_MASK
#define MK_PHASE_MASK 0xFF
#endif
#define IN(k) (((MK_PHASE_MASK >> (k)) & 1) && lo <= (k) && (k) < hi)
#define SEAM(k) do { if (IN(k) && IN((k) + 1)) xcd_barrier(bar); } while (0)

    if (IN(0)) { p0_prologue(F, args); }
    SEAM(0);
    if (IN(1)) {
        { pg8::Gemm gm{WSB(WS_XB), WSB(WS_WINT), M, NP, 4096}; pg8::StaticOrder S; S.init(M, NP, F.G, F.bid); pg8::EpiStore E{WSB(WS_H), NP};
          pg8::gemm_phase<pg8::EpiStore, pg8::StaticOrder, true, true>(F.lds, gm, S, E); }
        { pg8::Gemm gm{WSB(WS_MEMB), WSB(WS_WKVT), 512, 4096, 4096}; pg8::StaticOrder S; S.init(512, 4096, F.G, F.bid); pg8::EpiStore E{WSB(WS_KVMEM), 4096};
          pg8::gemm_phase<pg8::EpiStore, pg8::StaticOrder, true, true>(F.lds, gm, S, E); }
    }
    SEAM(1);
    if (IN(2)) {
        for (;;) { const int it = wq_next(F, CW_Q2); if (it >= 64 + 512 + 1024) break;

#ifndef MK_NO_CMP
            if (it < 64) compress_item(F, it);
#endif
#ifndef MK_NO_MEM
            if (it >= 64 && it < 576) mem_attn_item(F, it - 64);
#endif
#ifndef MK_NO_PREP
            if (it >= 576) gla_prep_item(F, args, it - 576);
#endif
        }
    }
    SEAM(2);
    if (IN(3)) {
        for (;;) { const int it = wq_next(F, CW_Q3); if (it >= 32 + 2048) break;

#ifndef MK_NO_SCAN
            if (it < 32) gla_scan_item(F, it);
#endif
#ifndef MK_NO_ATT
            if (it >= 32) nsa_attend_item(F, it - 32);
#endif
        }
    }
    SEAM(3);
    if (IN(4)) { gla_finalize(F, args); }
    SEAM(4);
    if (IN(5)) {
        pg8::Gemm gm{WSB(WS_GATED), WSB(WS_WBRT), 3 * M, 3 * 4096, 2048}; pg8::MergeOrder S; S.init(F.G, F.bid); pg8::EpiMerge E{WSB(WS_H), NP, H_MRG, IN_BMERGE(args), WSB(WS_MERGED)};
        pg8::gemm_phase<pg8::EpiMerge, pg8::MergeOrder, true, true>(F.lds, gm, S, E);
    }
    SEAM(5);
    if (IN(6)) {
        pg8::Gemm gm{WSB(WS_MERGED), WSB(WS_WOUTT), M, 4096, 4096}; pg8::StaticOrder S; S.init(M, 4096, F.G, F.bid); pg8::EpiOut E{IN_X(args), args.out, ALPHA};
        pg8::gemm_phase<pg8::EpiOut, pg8::StaticOrder, true, true>(F.lds, gm, S, E);
    }
    SEAM(6);
    if (IN(7)) { ln_rows(F, args); }
#undef IN
#undef SEAM
}

extern "C" void kernel_launch(void* const* d_in, const int* in_sizes, int n_in, void* d_out, int out_size, void* d_ws, size_t ws_size, hipStream_t stream) {
    static int grid = 0;
    if (grid == 0) {
        if (n_in != 20 || in_sizes[0] != M * DM || out_size != M * DM || ws_size < WS_END) { fprintf(stderr, "kernel_launch: unexpected problem (n_in %d in0 %d out %d ws %zu); nothing launched\n", n_in, n_in > 0 ? in_sizes[0] : -1, out_size, ws_size); grid = -1; return; }
        int dev = 0, cus = 0, per_cu = 0;
        if (hipGetDevice(&dev) != hipSuccess || hipDeviceGetAttribute(&cus, hipDeviceAttributeMultiprocessorCount, dev) != hipSuccess) { grid = -1; return; }
        if (hipFuncSetAttribute((const void*)mk_fwd, hipFuncAttributeMaxDynamicSharedMemorySize, LDS_BYTES) != hipSuccess) { fprintf(stderr, "kernel_launch: hipFuncSetAttribute failed\n"); grid = -1; return; }
        if (hipOccupancyMaxActiveBlocksPerMultiprocessor(&per_cu, (const void*)mk_fwd, NWAVES * 64, LDS_BYTES) != hipSuccess || per_cu < 1) { fprintf(stderr, "kernel_launch: occupancy query reports %d blocks per CU\n", per_cu); (void)hipGetLastError(); grid = -1; return; }
        grid = cus;
    }
    if (grid < 0) return;
    if (hipMemsetAsync((char*)d_ws + WS_CTL, 0, CTL_ZERO_BYTES, stream) != hipSuccess) return;
    Args a{};
    for (int i = 0; i < 20; ++i) a.in[i] = (const float*)d_in[i];
    a.out = (float*)d_out; a.ws = (unsigned char*)d_ws;
#if MK_SINGLE
    a.ph_lo = 0; a.ph_hi = N_PHASES;
    hipLaunchKernelGGL(mk_fwd, dim3(grid), dim3(NWAVES * 64), LDS_BYTES, stream, a);
#else
    for (int p = 0; p < N_PHASES; ++p) { a.ph_lo = p; a.ph_hi = p + 1; hipLaunchKernelGGL(mk_fwd, dim3(grid), dim3(NWAVES * 64), LDS_BYTES, stream, a); }
#endif
}
```

```cpp
#include <hip/hip_runtime.h>
#include <cstdio>
#include <cstdint>

#ifndef MK_SINGLE
#define MK_SINGLE 1
#endif

#define DI __device__ __forceinline__
#define LAS __attribute__((address_space(3)))
#define GAS __attribute__((address_space(1)))
typedef unsigned short bf16;
typedef short bf16x8 __attribute__((ext_vector_type(8)));
typedef short s16x4 __attribute__((ext_vector_type(4)));
typedef short v4i16_t __attribute__((ext_vector_type(4)));
typedef float f32x4 __attribute__((ext_vector_type(4)));
typedef float f32x2_t __attribute__((ext_vector_type(2)));
typedef __bf16 bf16x2_t __attribute__((ext_vector_type(2)));
typedef unsigned u32x4 __attribute__((ext_vector_type(4)));
typedef unsigned u32x2 __attribute__((ext_vector_type(2)));
typedef GAS unsigned gu32;
#define RLX_AGENT __ATOMIC_RELAXED, __HIP_MEMORY_SCOPE_AGENT

constexpr int DM = 4096, BATCH = 2, SEQ = 8192, M = BATCH * SEQ;
constexpr int D_IN = 29760;
constexpr int NP = 29952;
constexpr int H_GQ = 0, H_GK = 1024, H_GV = 2048, H_GZ = 4096, H_NQ = 6144, H_NKC = 8192, H_NVC = 8704, H_NKS = 9216, H_NVS = 9728,
              H_NKW = 10240, H_NVW = 10752, H_NZ = 11264, H_MQ = 13312, H_MZ = 15360, H_MRG = 17408, H_SM = 29696;
constexpr float ALPHA = 1.189207115002721f;
constexpr float LN_EPS = 1e-5f, RMS_EPS = 1e-6f;
constexpr float NEG = -1e30f;

__host__ __device__ __forceinline__ int win_src_col(int n) {
    if (n < 6144) return n;
    if (n < 13312) return n + 16;
    if (n < 29696) return n + 64;
    if (n < 29712) return n - 29696 + 6144;
    if (n < 29760) return n - 29712 + 13328;
    return -1;
}

constexpr size_t MiB = 1u << 20;
constexpr size_t WS_CTL = 0, CTL_ZERO_BYTES = 64 * 1024;
constexpr size_t WS_C1 = 512 * 1024;
constexpr size_t WS_WINT = 2 * MiB;
constexpr size_t WS_WKVT = 236 * MiB;
constexpr size_t WS_XB = 268 * MiB;
constexpr size_t WS_MEMB = 396 * MiB;
constexpr size_t WS_H = 400 * MiB;
constexpr size_t WS_KVMEM = 1336 * MiB;
constexpr size_t WS_WBRT = 1340 * MiB;
constexpr size_t WS_WOUTT = 1388 * MiB;
constexpr size_t WS_W1T = 1420 * MiB;
constexpr size_t WS_W2T = 1422 * MiB;
constexpr size_t WS_CMP = 1423 * MiB;
constexpr size_t WS_GDEC = 1425 * MiB;
constexpr size_t WS_QD = 1426 * MiB;
constexpr size_t WS_KEND = 1458 * MiB;
constexpr size_t WS_MERGED = 1490 * MiB;
constexpr size_t WS_END = 1618 * MiB;
constexpr size_t WS_GATED = 2 * MiB;
constexpr size_t WS_GO = 268 * MiB;
static_assert(WS_GATED + 3 * (size_t)M * 2048 * 2 <= WS_WKVT && WS_GO + (size_t)M * 2048 * 4 <= WS_MEMB, "overlays");
static_assert(WS_WINT + (size_t)NP * 4096 * 2 == WS_WKVT && WS_XB + (size_t)M * 4096 * 2 == WS_MEMB, "P1 treats [xb ; memb] and [w_in_t ; w_kv_t] as single matrices");
constexpr int CW_Q2 = 64, CW_Q3 = 128;
constexpr int CW_BAR = 4096;

constexpr int LDS_BYTES = 155648;
constexpr int MISC_OFF = LDS_BYTES - 256;
constexpr int NWAVES = 8;

DI float bflo(unsigned w) { return __uint_as_float(w << 16); }
DI float bfhi(unsigned w) { return __uint_as_float(w & 0xffff0000u); }
DI float bf2f(bf16 b) { return __uint_as_float(((unsigned)b) << 16); }
DI unsigned cvtpk(float lo, float hi) { f32x2_t v = {lo, hi}; bf16x2_t b = __builtin_convertvector(v, bf16x2_t); return __builtin_bit_cast(unsigned, b); }
DI f32x4 mfma16(bf16x8 a, bf16x8 b, f32x4 c) { return __builtin_amdgcn_mfma_f32_16x16x32_bf16(a, b, c, 0, 0, 0); }
DI bf16x8 pack2(f32x4 a, f32x4 b) { u32x4 p; p.x = cvtpk(a[0], a[1]); p.y = cvtpk(a[2], a[3]); p.z = cvtpk(b[0], b[1]); p.w = cvtpk(b[2], b[3]); return __builtin_bit_cast(bf16x8, p); }
DI s16x4 trread(const LAS char* p) { return __builtin_bit_cast(s16x4, __builtin_amdgcn_ds_read_tr16_b64_v4i16((LAS v4i16_t*)p)); }
DI bf16x8 tr_frag(const LAS char* img, int RS, int m0, int kA, int kB, int lane) {
    const int q = (lane & 15) >> 2, p = lane & 3;
    const s16x4 lo = trread(img + (kA + q) * RS + (m0 + 4 * p) * 2);
    const s16x4 hi = trread(img + (kB + q) * RS + (m0 + 4 * p) * 2);
    return __builtin_shufflevector(lo, hi, 0, 1, 2, 3, 4, 5, 6, 7);
}
DI float wave_sum(float v) {
#pragma unroll
    for (int o = 1; o < 64; o <<= 1) v += __shfl_xor(v, o);
    return v;
}
DI float sigmoidf_(float x) { return 1.f / (1.f + __expf(-x)); }
DI float siluf_(float x) { return x / (1.f + __expf(-x)); }
template <int ROWS, int CHUNKS> DI void g2l_tile(LAS char* dst, int dstRS, const char* src, size_t srcRS, int tid) {
#pragma unroll
    for (int it = 0; it < (ROWS * CHUNKS + 511) / 512; ++it) { const int idx = tid + it * 512;
        if ((ROWS * CHUNKS) % 512 == 0 || idx < ROWS * CHUNKS) { const int r = idx / CHUNKS, c = idx % CHUNKS;
            *(LAS u32x4*)(dst + r * dstRS + c * 16) = *(const u32x4*)(src + (size_t)r * srcRS + c * 16); } }
}
template <int ROWS, int CHUNKS> DI void pf_load(u32x4 (&v)[(ROWS * CHUNKS + 511) / 512], const char* src, size_t srcRS, int tid) {
#pragma unroll
    for (int it = 0; it < (ROWS * CHUNKS + 511) / 512; ++it) { const int idx = tid + it * 512;
        if ((ROWS * CHUNKS) % 512 == 0 || idx < ROWS * CHUNKS) { const int r = idx / CHUNKS, c = idx % CHUNKS; v[it] = *(const u32x4*)(src + (size_t)r * srcRS + c * 16); } }
}
template <int ROWS, int CHUNKS> DI void pf_store(const u32x4 (&v)[(ROWS * CHUNKS + 511) / 512], LAS char* dst, int dstRS, int tid) {
#pragma unroll
    for (int it = 0; it < (ROWS * CHUNKS + 511) / 512; ++it) { const int idx = tid + it * 512;
        if ((ROWS * CHUNKS) % 512 == 0 || idx < ROWS * CHUNKS) { const int r = idx / CHUNKS, c = idx % CHUNKS; *(LAS u32x4*)(dst + r * dstRS + c * 16) = v[it]; } }
}
namespace pg8 {
#define PG8_LAS __attribute__((address_space(3)))
typedef unsigned short bf16_t;
typedef short bf16x8 __attribute__((ext_vector_type(8)));
typedef float f32x4 __attribute__((ext_vector_type(4)));
typedef unsigned u32x4 __attribute__((ext_vector_type(4)));
constexpr int BM = 256, BK = 64, HALF = 128, HTB = HALF * BK * 2  , STAGE_BYTES = 8 * HTB, NXCD = 8, WGM = 8;

__host__ __device__ __forceinline__ int lds_byte(int r, int c) { const int st = (r >> 4) * 2 + (c >> 5), rr = r & 15, cc = c & 31, ob = rr * 64 + cc * 2; return st * 1024 + (ob ^ (((ob >> 9) & 1) << 5)); }
__host__ __device__ __forceinline__ void stage_rc(int b, int& R, int& C) { const int st = b / 1024, sb = b % 1024, swz = sb ^ (((sb >> 9) & 1) << 5); R = (st >> 1) * 16 + swz / 64; C = (st & 1) * 32 + (swz % 64) / 2; }
__host__ __device__ __forceinline__ int perm32(int rho) { const int n = rho >> 4, i = rho & 15; return 8 * (i >> 2) + 4 * n + (i & 3); }

struct Unit { int pm, pn; };
struct Gemm { const bf16_t* A; const bf16_t* Bt; int M, N, K; };

struct StaticOrder {
    int nM, nN, nwg, G, c;
    __host__ __device__ void init(int M, int N, int G_, int c_) { nM = M / BM; nN = N / BM; nwg = nM * nN; G = G_; c = c_; }
    __host__ __device__ bool next(int i, Unit& u) const {
        const long L = (long)i * G + c; if (L >= nwg) return false;
        int wgid = (int)L; { const int q = nwg / NXCD, r = nwg % NXCD, xcd = wgid % NXCD, off = wgid / NXCD; wgid = (xcd < r ? xcd * (q + 1) : r * (q + 1) + (xcd - r) * q) + off; }
        const int nig = WGM * nN, gid = wgid / nig, fm = gid * WGM, gsz = (nM - fm) < WGM ? (nM - fm) : WGM;
        u.pm = fm + ((wgid % nig) % gsz); u.pn = (wgid % nig) / gsz; return true;
    }
    __device__ __forceinline__ void a_ready(const Unit&) const {}
    __device__ __forceinline__ void done(const Unit&) const {}
};

__device__ __forceinline__ unsigned cvt_pk_bf16(float lo, float hi) { unsigned r; asm volatile("v_cvt_pk_bf16_f32 %0, %1, %2" : "=v"(r) : "v"(lo), "v"(hi)); return r; }
typedef float f32x2 __attribute__((ext_vector_type(2)));
struct EpiStore {
    static constexpr bool PERM = true, AFTER_DRAIN = false, RW = false;
    bf16_t* O; int ldc;
    __device__ __forceinline__ void operator()(const f32x4 (&acc)[2][2][4][2], const Unit& u, int wr, int wc, int fr, int fq) const {
        const int row0 = u.pm * BM + wr * 64 + fr, col0 = u.pn * BM + wc * 32 + 8 * fq;
#pragma unroll
        for (int ai = 0; ai < 2; ++ai)
#pragma unroll
            for (int m = 0; m < 4; ++m) { bf16_t* rowp = O + (size_t)(row0 + ai * HALF + m * 16) * ldc + col0;
#pragma unroll
                for (int bj = 0; bj < 2; ++bj) { const f32x4 v0 = acc[ai][bj][m][0], v1 = acc[ai][bj][m][1];
                    u32x4 w; w.x = cvt_pk_bf16(v0[0], v0[1]); w.y = cvt_pk_bf16(v0[2], v0[3]); w.z = cvt_pk_bf16(v1[0], v1[1]); w.w = cvt_pk_bf16(v1[2], v1[3]);
                    *(u32x4*)(rowp + bj * HALF) = w; } }
    }
};
struct EpiMerge {
    static constexpr bool PERM = true, AFTER_DRAIN = false, RW = true;
    const bf16_t* Hh; int ldh, mrg_col; const float* bmerge; bf16_t* MG;
    __device__ __forceinline__ bool rw(f32x4 (&acc)[2][2][4][2], const Unit& u, int wr, int wc, int fr, int fq) const {
        const int br = u.pm >> 6, pm = u.pm & 63, pn = u.pn & 15;
        const int row0 = pm * BM + wr * 64 + fr, col0 = pn * BM + wc * 32 + 8 * fq;
        const bool last = br == 2; const int brn = last ? 2 : br + 1;
#pragma unroll
        for (int bj = 0; bj < 2; ++bj) { const int col = col0 + bj * HALF;
            const f32x4 bd0 = *(const f32x4*)(bmerge + br * 4096 + col), bd1 = *(const f32x4*)(bmerge + br * 4096 + col + 4);
            const f32x4 bn0 = *(const f32x4*)(bmerge + brn * 4096 + col), bn1 = *(const f32x4*)(bmerge + brn * 4096 + col + 4);
#pragma unroll
            for (int ai = 0; ai < 2; ++ai)
#pragma unroll
                for (int m = 0; m < 4; ++m) { const int row = row0 + ai * HALF + m * 16;
                    const bf16_t* hp = Hh + (size_t)row * ldh + mrg_col + col;
                    const u32x4 gd = *(const u32x4*)(hp + br * 4096), gn = *(const u32x4*)(hp + brn * 4096);
                    const unsigned dw[4] = {gd.x, gd.y, gd.z, gd.w}, nw[4] = {gn.x, gn.y, gn.z, gn.w};
                    f32x4 f0, f1;
#pragma unroll
                    for (int j = 0; j < 4; ++j) {
                        const float d0 = ((j & 1) ? __uint_as_float(dw[j >> 1] & 0xffff0000u) : __uint_as_float(dw[j >> 1] << 16)) + bd0[j];
                        const float d1 = ((j & 1) ? __uint_as_float(dw[2 + (j >> 1)] & 0xffff0000u) : __uint_as_float(dw[2 + (j >> 1)] << 16)) + bd1[j];
                        const float n0 = ((j & 1) ? __uint_as_float(nw[j >> 1] & 0xffff0000u) : __uint_as_float(nw[j >> 1] << 16)) + bn0[j];
                        const float n1 = ((j & 1) ? __uint_as_float(nw[2 + (j >> 1)] & 0xffff0000u) : __uint_as_float(nw[2 + (j >> 1)] << 16)) + bn1[j];
                        const float num0 = last ? 1.f : 1.f + __expf(-n0), num1 = last ? 1.f : 1.f + __expf(-n1);
                        f0[j] = num0 / (1.f + __expf(-d0)); f1[j] = num1 / (1.f + __expf(-d1)); }
                    const f32x4 v0 = acc[ai][bj][m][0] * f0, v1 = acc[ai][bj][m][1] * f1;
                    acc[ai][bj][m][0] = v0; acc[ai][bj][m][1] = v1;
                    if (last) { u32x4 w; w.x = cvt_pk_bf16(v0[0], v0[1]); w.y = cvt_pk_bf16(v0[2], v0[3]); w.z = cvt_pk_bf16(v1[0], v1[1]); w.w = cvt_pk_bf16(v1[2], v1[3]);
                        *(u32x4*)(MG + (size_t)row * 4096 + col) = w; } } }
        return !last;
    }
};
struct EpiOut {
    static constexpr bool PERM = false, AFTER_DRAIN = false, RW = false;
    const float* X; float* C; float alpha;
    __device__ __forceinline__ void operator()(const f32x4 (&acc)[2][2][4][2], const Unit& u, int wr, int wc, int fr, int fq) const {
        const int row0 = u.pm * BM + wr * 64 + fr, col0 = u.pn * BM + wc * 32 + 4 * fq;
#pragma unroll
        for (int ai = 0; ai < 2; ++ai)
#pragma unroll
            for (int m = 0; m < 4; ++m) { const size_t off = (size_t)(row0 + ai * HALF + m * 16) * 4096 + col0;
#pragma unroll
                for (int bj = 0; bj < 2; ++bj)
#pragma unroll
                    for (int n = 0; n < 2; ++n) { const f32x4 xv = *(const f32x4*)(X + off + bj * HALF + n * 16); *(f32x4*)(C + off + bj * HALF + n * 16) = xv * alpha + acc[ai][bj][m][n]; } }
    }
};
struct MergeOrder {
    StaticOrder so;
    __host__ __device__ void init(int G_, int c_) { so.init(16384, 4096, G_, c_); }
    __host__ __device__ bool next(int i, Unit& u) const { Unit t; if (!so.next(i / 3, t)) return false; const int br = i % 3; u.pm = br * 64 + t.pm; u.pn = br * 16 + t.pn; return true; }
    __device__ __forceinline__ void a_ready(const Unit&) const {}
    __device__ __forceinline__ void done(const Unit&) const {}
};
struct H1Order {
    StaticOrder so;
    __host__ __device__ void init(int G_, int c_) { so.init(16384, 29952, G_, c_); }
    __host__ __device__ bool next(int i, Unit& u) const { if (so.next(i, u)) return true; const long e = (long)i * so.G + so.c - so.nwg; if (e < 32) { u.pm = 64 + (int)(e & 1); u.pn = 117 + (int)(e >> 1); return true; } return false; }
    __device__ __forceinline__ void a_ready(const Unit&) const {}
    __device__ __forceinline__ void done(const Unit&) const {}
};
struct EpiH1 {
    static constexpr bool PERM = true, AFTER_DRAIN = false, RW = false;
    bf16_t* O; int ldc; bf16_t* O2; int ldc2;
    __device__ __forceinline__ void operator()(const f32x4 (&acc)[2][2][4][2], const Unit& u, int wr, int wc, int fr, int fq) const {
        const bool ex = u.pm >= 64; bf16_t* base = ex ? O2 : O; const int ld = ex ? ldc2 : ldc;
        const int row0 = (ex ? u.pm - 64 : u.pm) * BM + wr * 64 + fr, col0 = (ex ? u.pn - 117 : u.pn) * BM + wc * 32 + 8 * fq;
#pragma unroll
        for (int ai = 0; ai < 2; ++ai)
#pragma unroll
            for (int m = 0; m < 4; ++m) { bf16_t* rowp = base + (size_t)(row0 + ai * HALF + m * 16) * ld + col0;
#pragma unroll
                for (int bj = 0; bj < 2; ++bj) { const f32x4 v0 = acc[ai][bj][m][0], v1 = acc[ai][bj][m][1];
                    u32x4 w; w.x = cvt_pk_bf16(v0[0], v0[1]); w.y = cvt_pk_bf16(v0[2], v0[3]); w.z = cvt_pk_bf16(v1[0], v1[1]); w.w = cvt_pk_bf16(v1[2], v1[3]);
                    *(u32x4*)(rowp + bj * HALF) = w; } }
    }
};
template <class Epi, class Sched, bool ALIGN_EPI = false, bool SP2 = false>
__device__ __forceinline__ void gemm_phase(PG8_LAS unsigned char* lds, const Gemm g, const Sched& S, const Epi& E) {
    const int tid = threadIdx.x, wid = __builtin_amdgcn_readfirstlane(tid >> 6), lane = tid & 63, wr = wid >> 2, wc = wid & 3, fr = lane & 15, fq = lane >> 4;
    const int K = g.K, nt = K / BK;
    unsigned voffA[2], voffB[2];
#pragma unroll
    for (int i = 0; i < 2; ++i) { int R, C; stage_rc(tid * 16 + i * 8192, R, C); const int Rb = Epi::PERM ? ((R & ~31) + perm32(R & 31)) : R;
        voffA[i] = (unsigned)(R * K + C) * 2u; voffB[i] = (unsigned)(Rb * K + C) * 2u; }
    const size_t kstep = (size_t)(BK * 2);
    const size_t hstep = (size_t)HALF * K * 2;
    const size_t tstep = 2 * hstep;
    const unsigned ldsw = (unsigned)wid * 1024u;
    const int aoff = lds_byte(wr * 64 + fr, fq * 8), boff = lds_byte(wc * 32 + fr, fq * 8);
#define PG8_SA(b, h) (((b) * 2 + (h)) * HTB)
#define PG8_SB(b, h) ((4 + (b) * 2 + (h)) * HTB)
#define PG8_STAGE(bufoff, gbase, voff) do { _Pragma("unroll") for (int _i = 0; _i < 2; ++_i) \
        __builtin_amdgcn_global_load_lds((const unsigned*)((const char*)(gbase) + (voff)[_i]), (PG8_LAS unsigned*)(lds + (bufoff) + ldsw + _i * 8192), 16, 0, 0); } while (0)
#define PG8_LDA(dst, b, h) do { _Pragma("unroll") for (int m = 0; m < 4; ++m) _Pragma("unroll") for (int k = 0; k < 2; ++k) dst[m][k] = *(const PG8_LAS bf16x8*)(lds + PG8_SA(b, h) + aoff + m * 2048 + k * 1024); } while (0)
#define PG8_LDB(dst, b, h) do { _Pragma("unroll") for (int n = 0; n < 2; ++n) _Pragma("unroll") for (int k = 0; k < 2; ++k) dst[n][k] = *(const PG8_LAS bf16x8*)(lds + PG8_SB(b, h) + boff + n * 2048 + k * 1024); } while (0)
#define PG8_MMA(ai, bj, At, Bt) do { __builtin_amdgcn_s_setprio(1); _Pragma("unroll") for (int m = 0; m < 4; ++m) _Pragma("unroll") for (int n = 0; n < 2; ++n) _Pragma("unroll") for (int k = 0; k < 2; ++k) \
        acc[ai][bj][m][n] = __builtin_amdgcn_mfma_f32_16x16x32_bf16(Bt[n][k], At[m][k], acc[ai][bj][m][n], 0, 0, 0); __builtin_amdgcn_s_setprio(0); } while (0)
#define PG8_WAIT_V(n) asm volatile("s_waitcnt vmcnt(" #n ")" ::: "memory")
#define PG8_WAIT_L(n) asm volatile("s_waitcnt lgkmcnt(" #n ")" ::: "memory")
#define PG8_BAR __builtin_amdgcn_s_barrier()
#define PG8_SCHED __builtin_amdgcn_sched_barrier(0)
    Unit cur, nxt; int ui = 0;
    if (!S.next(0, cur)) return;
    f32x4 acc[2][2][4][2];
#pragma unroll
    for (int a = 0; a < 2; ++a)
#pragma unroll
        for (int b = 0; b < 2; ++b)
#pragma unroll
            for (int m = 0; m < 4; ++m)
#pragma unroll
                for (int n = 0; n < 2; ++n) acc[a][b][m][n] = (f32x4){0.f, 0.f, 0.f, 0.f};
    bf16x8 At[4][2], B0[2][2], B1[2][2];
    const char* cA = (const char*)g.A + (size_t)cur.pm * tstep; const char* cB = (const char*)g.Bt + (size_t)cur.pn * tstep;
    S.a_ready(cur);
    if constexpr (SP2) {
        PG8_STAGE(PG8_SB(0, 0), cB, voffB); PG8_STAGE(PG8_SB(0, 1), cB + hstep, voffB); PG8_STAGE(PG8_SA(0, 0), cA, voffA); PG8_STAGE(PG8_SA(0, 1), cA + hstep, voffA);
        if (wr == 1) PG8_BAR;
        PG8_WAIT_V(2); PG8_BAR;
        PG8_STAGE(PG8_SB(1, 0), cB + kstep, voffB); PG8_STAGE(PG8_SA(1, 0), cA + kstep, voffA); PG8_STAGE(PG8_SB(1, 1), cB + hstep + kstep, voffB);
        PG8_WAIT_V(6); PG8_BAR;
    } else {
        PG8_STAGE(PG8_SB(0, 0), cB, voffB); PG8_STAGE(PG8_SA(0, 0), cA, voffA); PG8_STAGE(PG8_SB(0, 1), cB + hstep, voffB); PG8_STAGE(PG8_SA(0, 1), cA + hstep, voffA);
        if (wr == 1) PG8_BAR;
        PG8_WAIT_V(4); PG8_BAR;
        PG8_STAGE(PG8_SB(1, 0), cB + kstep, voffB); PG8_STAGE(PG8_SA(1, 0), cA + kstep, voffA); PG8_STAGE(PG8_SB(1, 1), cB + hstep + kstep, voffB);
        PG8_WAIT_V(6); PG8_BAR;
    }
    for (;;) {
        const bool has_next = S.next(ui + 1, nxt);
        const char* nA = has_next ? (const char*)g.A + (size_t)nxt.pm * tstep : cA; const char* nB = has_next ? (const char*)g.Bt + (size_t)nxt.pn * tstep : cB;
        for (int t = 0; t < nt; t += 2) {
            const bool last = (t == nt - 2);
            const char* a1 = cA + (size_t)(t + 1) * kstep;
            const char* a2 = last ? nA : cA + (size_t)(t + 2) * kstep; const char* b2 = last ? nB : cB + (size_t)(t + 2) * kstep;
            const char* a3 = a2 + kstep; const char* b3 = b2 + kstep;
            if (last && has_next) S.a_ready(nxt);
            if constexpr (SP2) {
            PG8_LDB(B0, 0, 0); PG8_LDB(B1, 0, 1); PG8_SCHED; PG8_LDA(At, 0, 0); PG8_STAGE(PG8_SA(1, 1), a1 + hstep, voffA);
            PG8_WAIT_V(8); PG8_WAIT_L(0); PG8_BAR; PG8_MMA(0, 0, At, B0); PG8_MMA(0, 1, At, B1); PG8_BAR; PG8_SCHED;
            PG8_LDA(At, 0, 1); PG8_STAGE(PG8_SB(0, 0), b2, voffB); PG8_STAGE(PG8_SB(0, 1), b2 + hstep, voffB); PG8_STAGE(PG8_SA(0, 0), a2, voffA);
            PG8_WAIT_V(8); PG8_WAIT_L(0); PG8_BAR; PG8_MMA(1, 0, At, B0); PG8_MMA(1, 1, At, B1); PG8_BAR; PG8_SCHED;
            PG8_LDB(B0, 1, 0); PG8_LDB(B1, 1, 1); PG8_SCHED; PG8_LDA(At, 1, 0); PG8_STAGE(PG8_SA(0, 1), a2 + hstep, voffA);
            PG8_WAIT_V(8); PG8_WAIT_L(0); PG8_BAR; PG8_MMA(0, 0, At, B0); PG8_MMA(0, 1, At, B1); PG8_BAR; PG8_SCHED;
            PG8_LDA(At, 1, 1); PG8_STAGE(PG8_SB(1, 0), b3, voffB); PG8_STAGE(PG8_SB(1, 1), b3 + hstep, voffB); PG8_STAGE(PG8_SA(1, 0), a3, voffA);
            PG8_WAIT_V(8); PG8_WAIT_L(0); PG8_BAR; PG8_MMA(1, 0, At, B0); PG8_MMA(1, 1, At, B1); PG8_BAR; PG8_SCHED;
            } else {
            PG8_LDB(B0, 0, 0); PG8_SCHED; PG8_LDA(At, 0, 0); PG8_STAGE(PG8_SA(1, 1), a1 + hstep, voffA);
            PG8_WAIT_L(8); PG8_BAR; PG8_WAIT_L(0); PG8_MMA(0, 0, At, B0); PG8_BAR; PG8_SCHED;
            PG8_LDB(B1, 0, 1); PG8_STAGE(PG8_SB(0, 0), b2, voffB);
            PG8_BAR; PG8_WAIT_L(0); PG8_MMA(0, 1, At, B1); PG8_BAR;
            PG8_LDA(At, 0, 1); PG8_STAGE(PG8_SA(0, 0), a2, voffA);
            PG8_BAR; PG8_WAIT_L(0); PG8_MMA(1, 0, At, B0); PG8_BAR; PG8_SCHED;
            PG8_STAGE(PG8_SB(0, 1), b2 + hstep, voffB);
            PG8_WAIT_V(6); PG8_BAR; PG8_MMA(1, 1, At, B1); PG8_BAR;
            PG8_LDB(B0, 1, 0); PG8_SCHED; PG8_LDA(At, 1, 0); PG8_STAGE(PG8_SA(0, 1), a2 + hstep, voffA);
            PG8_WAIT_L(8); PG8_BAR; PG8_WAIT_L(0); PG8_MMA(0, 0, At, B0); PG8_BAR; PG8_SCHED;
            PG8_LDB(B1, 1, 1); PG8_STAGE(PG8_SB(1, 0), b3, voffB);
            PG8_BAR; PG8_WAIT_L(0); PG8_MMA(0, 1, At, B1); PG8_BAR;
            PG8_LDA(At, 1, 1); PG8_STAGE(PG8_SA(1, 0), a3, voffA);
            PG8_BAR; PG8_WAIT_L(0); PG8_MMA(1, 0, At, B0); PG8_BAR; PG8_SCHED;
            PG8_STAGE(PG8_SB(1, 1), b3 + hstep, voffB);
            PG8_WAIT_V(6); PG8_BAR; PG8_MMA(1, 1, At, B1); PG8_BAR;
            }
        }
        if constexpr (ALIGN_EPI) { if (wr == 0) PG8_BAR; }
        bool keep_acc = false;
        if constexpr (!Epi::AFTER_DRAIN) { if constexpr (Epi::RW) keep_acc = E.rw(acc, cur, wr, wc, fr, fq); else E(acc, cur, wr, wc, fr, fq); S.done(cur); }
        if (!has_next) break;
        if (!keep_acc) {
#pragma unroll
        for (int a = 0; a < 2; ++a)
#pragma unroll
            for (int b = 0; b < 2; ++b)
#pragma unroll
                for (int m = 0; m < 4; ++m)
#pragma unroll
                    for (int n = 0; n < 2; ++n) acc[a][b][m][n] = (f32x4){0.f, 0.f, 0.f, 0.f};
        }
        cur = nxt; cA = nA; cB = nB; ++ui;
        if constexpr (ALIGN_EPI) { if (wr == 1) PG8_BAR; }
    }
    PG8_WAIT_V(0);
    if constexpr (!ALIGN_EPI) { if (wr == 0) PG8_BAR; }
    PG8_BAR;
    if constexpr (Epi::AFTER_DRAIN) { E.fused(acc, cur, wr, wc, fr, fq, lds, wid, lane); S.done(cur); }
#undef PG8_SA
#undef PG8_SB
#undef PG8_STAGE
#undef PG8_LDA
#undef PG8_LDB
#undef PG8_MMA
#undef PG8_WAIT_V
#undef PG8_WAIT_L
#undef PG8_BAR
#undef PG8_SCHED
}
}
#define XB_TMO      128
#define XB_XCNT(j)  (256  + 64 * (j))
#define XB_XSUB(j)  (1280 + 64 * (j))
#define XB_XGEN(j)  (2304 + 64 * (j))
#define XB_TOP      3328
#define XB_TOPGEN   3392
#define XCD_BAR_WORDS 3456
#define XB_SPIN_CAP (1u << 18)

__device__ __forceinline__ unsigned xb_ld(unsigned* p)              { return __hip_atomic_load(p, __ATOMIC_RELAXED, __HIP_MEMORY_SCOPE_AGENT); }
__device__ __forceinline__ unsigned xb_add(unsigned* p, unsigned v) { return __hip_atomic_fetch_add(p, v, __ATOMIC_RELAXED, __HIP_MEMORY_SCOPE_AGENT); }
__device__ __forceinline__ unsigned xb_xcc_id() { return (unsigned)__builtin_amdgcn_s_getreg((3 << 11) | 20) & 0xFu; }
#define XB_SPIN(cond, bar) do { unsigned _sp = 0; while (cond) { __builtin_amdgcn_s_sleep(1); \
    if ((++_sp & 255u) == 0u) { if (xb_ld(&(bar)[XB_TMO])) break; if (_sp > XB_SPIN_CAP) { atomicAdd(&(bar)[XB_TMO], 1u); break; } } } } while (0)

struct XcdBarrier {
    unsigned* bar; unsigned x;
    volatile LAS unsigned* st;
};

__device__ __forceinline__ XcdBarrier xcd_barrier_post(unsigned* bar, volatile LAS unsigned* st) {
    XcdBarrier b; b.bar = bar; b.x = xb_xcc_id(); b.st = st;
    if (threadIdx.x == 0) (void)xb_add(&bar[XB_XCNT(b.x)], 1u);
    return b;
}
__device__ __forceinline__ void xcd_barrier_complete(unsigned* bar, unsigned x, unsigned& nloc, unsigned& nx) {
    const unsigned G = gridDim.x * gridDim.y * gridDim.z;
    unsigned sum, cnt, mine, sp = 0u;
    for (;;) {
        sum = 0u; cnt = 0u; mine = 0u;
#pragma unroll
        for (unsigned j = 0; j < 16; ++j) { const unsigned c = xb_ld(&bar[XB_XCNT(j)]); sum += c; cnt += (c > 0u) ? 1u : 0u; mine = (j == x) ? c : mine; }
        if (sum == G) break;
        __builtin_amdgcn_s_sleep(1);
        if ((++sp & 255u) == 0u) { if (xb_ld(&bar[XB_TMO])) break; if (sp > XB_SPIN_CAP) { atomicAdd(&bar[XB_TMO], 1u); break; } }
    }
    nloc = mine > 0u ? mine : 1u; nx = cnt > 0u ? cnt : 1u;
}

__device__ __forceinline__ void xcd_barrier(const XcdBarrier& b) {
    asm volatile("s_waitcnt vmcnt(0)" ::: "memory");
    __syncthreads();
    if (threadIdx.x == 0) {
        unsigned* bar = b.bar;
        __builtin_amdgcn_s_waitcnt(0);
        unsigned nloc = b.st[0], nx = b.st[1];
        if (nloc == 0u) { xcd_barrier_complete(bar, b.x, nloc, nx); b.st[0] = nloc; b.st[1] = nx; }
        const unsigned old = xb_add(&bar[XB_XSUB(b.x)], 1u);
        const unsigned gen = old / nloc;
        if (old + 1u == (gen + 1u) * nloc) {
            __builtin_amdgcn_fence(__ATOMIC_RELEASE, "agent");
            asm volatile("s_waitcnt vmcnt(0)" ::: "memory");
            const unsigned og = xb_add(&bar[XB_TOP], 1u);
            const unsigned tg = og / nx;
            if (og + 1u == (tg + 1u) * nx) xb_add(&bar[XB_TOPGEN], 1u);
            else XB_SPIN(xb_ld(&bar[XB_TOPGEN]) == tg, bar);
            __builtin_amdgcn_fence(__ATOMIC_ACQUIRE, "agent");
            xb_add(&bar[XB_XGEN(b.x)], 1u);
            asm volatile("s_waitcnt vmcnt(0)" ::: "memory");
        } else {
            XB_SPIN(xb_ld(&bar[XB_XGEN(b.x)]) == gen, bar);
            __builtin_amdgcn_fence(__ATOMIC_ACQUIRE, "agent");
            asm volatile("s_waitcnt vmcnt(0)" ::: "memory");
        }
    }
    __syncthreads();
}
#define LDS_WAIT() asm volatile("s_waitcnt lgkmcnt(0)" ::: "memory")
struct Frame {
    LAS unsigned char* lds;
    volatile LAS unsigned* MISC;
    gu32* ctl;
    int tid, lane, wave, G, bid;
    unsigned char* ws;
};
struct Args { const float* in[20]; float* out; unsigned char* ws; int ph_lo, ph_hi; };
#define IN_X(A) ((A).in[0])
#define IN_MEM(A) ((A).in[1])
#define IN_WIN(A) ((A).in[2])
#define IN_BMERGE(A) ((A).in[3])
#define IN_WA2(A) ((A).in[4])
#define IN_BA(A) ((A).in[5])
#define IN_NORMG(A) ((A).in[6])
#define IN_PEK(A) ((A).in[7])
#define IN_PEV(A) ((A).in[8])
#define IN_WK1(A) ((A).in[9])
#define IN_WK2(A) ((A).in[10])
#define IN_WV1(A) ((A).in[11])
#define IN_WV2(A) ((A).in[12])
#define IN_WKV(A) ((A).in[13])
#define IN_WOUT(A) ((A).in[17])
#define IN_LNG(A) ((A).in[18])
#define IN_LNB(A) ((A).in[19])
#define WSB(off) ((bf16*)(F.ws + (off)))
#define WSF(off) ((float*)(F.ws + (off)))

DI int wq_next(Frame& F, int cw) {
    __syncthreads();
    if (F.tid == 0) F.MISC[0] = __hip_atomic_fetch_add(F.ctl + cw, 1u, RLX_AGENT);
    __syncthreads();
    return (int)F.MISC[0];
}

template <class Map> DI void transpose_item(const float* W, int K, int Nsrc, bf16* WT, LAS float* scr, int kb, int nb, int lane, Map map) {
    const int k0 = 64 * kb, n0 = 64 * nb;
    const int c4 = lane & 15, kq = lane >> 4;
    const int ns = map(n0 + 4 * c4);
    f32x4 v[16];
#pragma unroll
    for (int it = 0; it < 16; ++it) v[it] = ns >= 0 ? *(const f32x4*)(W + (size_t)(k0 + 4 * it + kq) * Nsrc + ns) : (f32x4){0.f, 0.f, 0.f, 0.f};
#pragma unroll
    for (int it = 0; it < 16; ++it) { LAS float* p = scr + (4 * it + kq) * 65 + 4 * c4; p[0] = v[it][0]; p[1] = v[it][1]; p[2] = v[it][2]; p[3] = v[it][3]; }
    LDS_WAIT(); asm volatile("" ::: "memory");
    const int c = lane & 7;
#pragma unroll
    for (int j = 0; j < 8; ++j) { const int n = (lane >> 3) + 8 * j; const LAS float* s = scr + (8 * c) * 65 + n;
        u32x4 o; o.x = cvtpk(s[0 * 65], s[1 * 65]); o.y = cvtpk(s[2 * 65], s[3 * 65]); o.z = cvtpk(s[4 * 65], s[5 * 65]); o.w = cvtpk(s[6 * 65], s[7 * 65]);
        *(GAS u32x4*)(WT + (size_t)(n0 + n) * K + k0 + 8 * c) = o; }
    LDS_WAIT(); asm volatile("" ::: "memory");
}
struct IdMap { DI int operator()(int n) const { return n; } };
struct WinMap { DI int operator()(int n) const { return win_src_col(n); } };

DI void cvt_rows_bf16(const float* src, bf16* dst, size_t n8, size_t g0, size_t gstride) {
    for (size_t i = g0; i < n8; i += 4 * gstride) { f32x4 a[4], b[4];
#pragma unroll
        for (int u = 0; u < 4; ++u) { const size_t k = i + u * gstride; if (k < n8) { a[u] = ((const f32x4*)src)[2 * k]; b[u] = ((const f32x4*)src)[2 * k + 1]; } }
#pragma unroll
        for (int u = 0; u < 4; ++u) { const size_t k = i + u * gstride; if (k < n8) { u32x4 o; o.x = cvtpk(a[u][0], a[u][1]); o.y = cvtpk(a[u][2], a[u][3]); o.z = cvtpk(b[u][0], b[u][1]); o.w = cvtpk(b[u][2], b[u][3]); ((u32x4*)dst)[k] = o; } } }
}

DI void p0_prologue(Frame& F, const Args& A) {
    LAS float* scr = (LAS float*)(F.lds + F.wave * 16896);
    const int gw = F.bid * NWAVES + F.wave, NGW = F.G * NWAVES;
    constexpr int I_WIN = 64 * (NP / 64), I_KV = 64 * 64, I_BR = 32 * 64, I_OUT = 64 * 64, I_W1 = 64 * 2, I_W2 = 2 * 2;
    constexpr int NITEMS = I_WIN + I_KV + 3 * I_BR + I_OUT + 2 * I_W1 + 2 * I_W2;
    for (int it = gw; it < NITEMS; it += NGW) {
        int r = it;
        if (r < I_WIN) { transpose_item(IN_WIN(A), 4096, D_IN, WSB(WS_WINT), scr, r / (NP / 64), r % (NP / 64), F.lane, WinMap()); continue; } r -= I_WIN;
        if (r < I_KV) { transpose_item(IN_WKV(A), 4096, 4096, WSB(WS_WKVT), scr, r / 64, r % 64, F.lane, IdMap()); continue; } r -= I_KV;
        if (r < 3 * I_BR) { const int br = r / I_BR, q = r % I_BR; transpose_item(br == 0 ? A.in[14] : (br == 1 ? A.in[15] : A.in[16]), 2048, 4096, WSB(WS_WBRT) + (size_t)br * 4096 * 2048, scr, q / 64, q % 64, F.lane, IdMap()); continue; } r -= 3 * I_BR;
        if (r < I_OUT) { transpose_item(IN_WOUT(A), 4096, 4096, WSB(WS_WOUTT), scr, r / 64, r % 64, F.lane, IdMap()); continue; } r -= I_OUT;
        if (r < 2 * I_W1) { const int kv = r / I_W1, q = r % I_W1; transpose_item(kv ? IN_WV1(A) : IN_WK1(A), 4096, 128, WSB(WS_W1T) + (size_t)kv * 128 * 4096, scr, q / 2, q % 2, F.lane, IdMap()); continue; } r -= 2 * I_W1;
        { const int kv = r / I_W2, q = r % I_W2; transpose_item(kv ? IN_WV2(A) : IN_WK2(A), 128, 128, WSB(WS_W2T) + (size_t)kv * 128 * 128, scr, q / 2, q % 2, F.lane, IdMap()); }
    }
    const size_t gt = (size_t)F.bid * 512 + F.tid, GT = (size_t)F.G * 512;
    cvt_rows_bf16(IN_X(A), WSB(WS_XB), (size_t)M * DM / 8, gt, GT);
    cvt_rows_bf16(IN_MEM(A), WSB(WS_MEMB), (size_t)512 * DM / 8, gt, GT);
    for (int o = gw; o < 256; o += NGW) { const int kv = o >> 7, j = o & 127; const float* pe = kv ? IN_PEV(A) : IN_PEK(A); const float* w1 = kv ? IN_WV1(A) : IN_WK1(A);
        float s = 0.f; for (int k = F.lane; k < 4096; k += 64) s += pe[k] * w1[(size_t)k * 128 + j];
        s = wave_sum(s); if (F.lane == 0) WSF(WS_C1)[o] = s; }
}
DI void mem_attn_item(Frame& F, int item) {
    const int tile = item & 63, head = (item >> 6) & 3, b = item >> 8;
    int tid = F.tid; asm volatile("" : "+v"(tid)); const int lane = tid & 63, w = __builtin_amdgcn_readfirstlane(tid >> 6); const int i = lane & 15, g = lane >> 4;
    const int tok = b * SEQ + tile * 128 + 16 * w + i;
    LAS char* KL = (LAS char*)F.lds;
    LAS char* VL = (LAS char*)F.lds + 36864;
    const bf16* qrow = WSB(WS_H) + (size_t)tok * NP + H_MQ + head * 512;
    bf16x8 qf[16];
#pragma unroll
    for (int s = 0; s < 16; ++s) qf[s] = *(const bf16x8*)(qrow + 32 * s + 8 * g);
    f32x4 sacc[16];
#pragma unroll
    for (int kt = 0; kt < 16; ++kt) sacc[kt] = (f32x4){0.f, 0.f, 0.f, 0.f};
    const char* kbase = (const char*)(WSB(WS_KVMEM) + (size_t)(b * 256) * 4096 + head * 512);
#pragma unroll
    for (int dc = 0; dc < 8; ++dc) {
        __syncthreads();
        g2l_tile<256, 8>(KL, 144, kbase + dc * 128, 8192, tid);
        __syncthreads();
#pragma unroll
        for (int s2 = 0; s2 < 2; ++s2)
#pragma unroll
            for (int kt = 0; kt < 16; ++kt) { const bf16x8 a = *(const LAS bf16x8*)(KL + (16 * kt + i) * 144 + (s2 * 32 + 8 * g) * 2); sacc[kt] = mfma16(a, qf[dc * 2 + s2], sacc[kt]); }
    }
    const float scale = 0.04419417382415922f;
    float mx = NEG;
#pragma unroll
    for (int kt = 0; kt < 16; ++kt)
#pragma unroll
        for (int r = 0; r < 4; ++r) mx = fmaxf(mx, sacc[kt][r]);
    mx = fmaxf(mx, __shfl_xor(mx, 16)); mx = fmaxf(mx, __shfl_xor(mx, 32));
    float sum = 0.f;
#pragma unroll
    for (int kt = 0; kt < 16; ++kt)
#pragma unroll
        for (int r = 0; r < 4; ++r) { const float p = __expf((sacc[kt][r] - mx) * scale); sacc[kt][r] = p; sum += p; }
    sum += __shfl_xor(sum, 16); sum += __shfl_xor(sum, 32);
    const float inv = 1.f / sum;
    bf16x8 pf[8];
#pragma unroll
    for (int s = 0; s < 8; ++s) pf[s] = pack2(sacc[2 * s], sacc[2 * s + 1]);
    const char* vbase = (const char*)(WSB(WS_KVMEM) + (size_t)(b * 256) * 4096 + 2048 + head * 512);
    const bf16* zrow = WSB(WS_H) + (size_t)tok * NP + H_MZ + head * 512;
    bf16* orow = WSB(WS_GATED) + (size_t)2 * M * 2048 + (size_t)tok * 2048 + head * 512;
#pragma unroll 1
    for (int dcv = 0; dcv < 4; ++dcv) {
        __syncthreads();
        g2l_tile<256, 16>(VL, 272, vbase + dcv * 256, 8192, tid);
        __syncthreads();
        f32x4 oacc[8];
#pragma unroll
        for (int dt = 0; dt < 8; ++dt) oacc[dt] = (f32x4){0.f, 0.f, 0.f, 0.f};
#pragma unroll
        for (int s = 0; s < 8; ++s)
#pragma unroll
            for (int dt = 0; dt < 8; ++dt) { const bf16x8 a = tr_frag(VL, 272, 16 * dt, 32 * s + 4 * g, 32 * s + 16 + 4 * g, lane); oacc[dt] = mfma16(a, pf[s], oacc[dt]); }
#pragma unroll
        for (int dt = 0; dt < 8; ++dt) { const int d0 = dcv * 128 + 16 * dt + 4 * g;
            const u32x2 z = *(const u32x2*)(zrow + d0);
            const float o0 = oacc[dt][0] * inv * siluf_(bflo(z.x)), o1 = oacc[dt][1] * inv * siluf_(bfhi(z.x)), o2 = oacc[dt][2] * inv * siluf_(bflo(z.y)), o3 = oacc[dt][3] * inv * siluf_(bfhi(z.y));
            u32x2 o; o.x = cvtpk(o0, o1); o.y = cvtpk(o2, o3); *(u32x2*)(orow + d0) = o; }
    }
}

DI void compress_item(Frame& F, int item) {
    const int ntile = item & 3, g = (item >> 2) & 3, b = (item >> 4) & 1, kv = item >> 5;
    int tid = F.tid; asm volatile("" : "+v"(tid)); const int lane = tid & 63, w = __builtin_amdgcn_readfirstlane(tid >> 6); const int i = lane & 15, gq = lane >> 4; (void)tid;
    const int n = ntile * 128 + 16 * w + i, nn = n < 510 ? n : 510;
    const bf16* xbase = WSB(WS_H) + (size_t)(b * SEQ + 16 * nn) * NP + (kv ? H_NVC : H_NKC) + g * 128;
    const bf16* w1t = WSB(WS_W1T) + (size_t)kv * 128 * 4096;
    const bf16* w2t = WSB(WS_W2T) + (size_t)kv * 128 * 128;
    f32x4 acc[8];
#pragma unroll
    for (int jt = 0; jt < 8; ++jt) acc[jt] = *(const f32x4*)(WSF(WS_C1) + kv * 128 + 16 * jt + 4 * gq);
#pragma unroll 2
    for (int s = 0; s < 128; ++s) {
        const bf16x8 bx = *(const bf16x8*)(xbase + (size_t)(s >> 2) * NP + (s & 3) * 32 + 8 * gq);
#pragma unroll
        for (int jt = 0; jt < 8; ++jt) { const bf16x8 aw = *(const bf16x8*)(w1t + (size_t)(16 * jt + i) * 4096 + 32 * s + 8 * gq); acc[jt] = mfma16(aw, bx, acc[jt]); }
    }
#pragma unroll
    for (int jt = 0; jt < 8; ++jt)
#pragma unroll
        for (int r = 0; r < 4; ++r) acc[jt][r] = siluf_(acc[jt][r]);
    bf16x8 hf[4];
#pragma unroll
    for (int s = 0; s < 4; ++s) hf[s] = pack2(acc[2 * s], acc[2 * s + 1]);
    bf16* orow = WSB(WS_CMP) + ((size_t)((kv * 2 + b) * 4 + g) * 512 + n) * 128;
#pragma unroll
    for (int jt = 0; jt < 8; ++jt) {
        f32x4 o = (f32x4){0.f, 0.f, 0.f, 0.f};
#pragma unroll
        for (int s = 0; s < 4; ++s) { const bf16* wr_ = w2t + (size_t)(16 * jt + i) * 128 + 32 * s + 4 * gq;
            const s16x4 lo = *(const s16x4*)wr_, hi = *(const s16x4*)(wr_ + 16);
            const bf16x8 aw = __builtin_shufflevector(lo, hi, 0, 1, 2, 3, 4, 5, 6, 7);
            o = mfma16(aw, hf[s], o); }
        u32x2 ov; if (n <= 510) { ov.x = cvtpk(o[0], o[1]); ov.y = cvtpk(o[2], o[3]); } else { ov.x = 0u; ov.y = 0u; }
        *(u32x2*)(orow + 16 * jt + 4 * gq) = ov;
    }
}
DI void gla_prep_item(Frame& F, const Args& A, int item) {
    const int n = item & 127, h = (item >> 7) & 3, b = item >> 9;
    const int tok0 = b * SEQ + 64 * n;
    int tid = F.tid; asm volatile("" : "+v"(tid)); const int lane = tid & 63, w = __builtin_amdgcn_readfirstlane(tid >> 6); const int i = lane & 15, g = lane >> 4;
    LAS float* LA = (LAS float*)F.lds;
    LAS char* VL = (LAS char*)F.lds;
    LAS char* QL = (LAS char*)F.lds + 66560;
    LAS char* KL = (LAS char*)F.lds + 100352;
    LAS float* GA = (LAS float*)(F.lds + 134144);
    LAS u32x4* ATT = (LAS u32x4*)(F.lds + 138240);
    if (tid < 128) { const int c = tid >> 1, hf = tid & 1; const u32x4 v = *(const u32x4*)(WSB(WS_H) + (size_t)(tok0 + c) * NP + H_SM + 8 * hf);
        LAS float* gp = GA + c * 16 + 8 * hf; gp[0] = bflo(v.x); gp[1] = bfhi(v.x); gp[2] = bflo(v.y); gp[3] = bfhi(v.y); gp[4] = bflo(v.z); gp[5] = bfhi(v.z); gp[6] = bflo(v.w); gp[7] = bfhi(v.w); }
    __syncthreads();
    { const int d = tid & 255, hf = tid >> 8; float wa[16];
#pragma unroll
      for (int j = 0; j < 16; ++j) wa[j] = IN_WA2(A)[j * 1024 + h * 256 + d];
      const float ba = IN_BA(A)[h * 256 + d]; float run = 0.f;
      for (int cc = 0; cc < 32; ++cc) { const int c = hf * 32 + cc; float lg = ba;
#pragma unroll
          for (int j = 0; j < 16; ++j) lg += GA[c * 16 + j] * wa[j];
          const float ls = -(fmaxf(-lg, 0.f) + __logf(1.f + __expf(-fabsf(lg))));
          run += ls * 0.0625f; LA[c * 256 + d] = run; } }
    __syncthreads();
#pragma unroll 1
    for (int it = 0; it < 4; ++it) { const int u = tid + 512 * it, c = u >> 5, d0 = (u & 31) * 8;
        const u32x4 qv = *(const u32x4*)(WSB(WS_H) + (size_t)(tok0 + c) * NP + H_GQ + h * 256 + d0);
        const u32x4 kv = *(const u32x4*)(WSB(WS_H) + (size_t)(tok0 + c) * NP + H_GK + h * 256 + d0);
        const unsigned qw[4] = {qv.x, qv.y, qv.z, qv.w}, kw[4] = {kv.x, kv.y, kv.z, kv.w};
        float qd[8], kd[8], ke[8];
#pragma unroll
        for (int e = 0; e < 8; ++e) { const int d = d0 + e; const float o31 = LA[31 * 256 + d], bl = LA[63 * 256 + d] + o31, bc = LA[c * 256 + d] + (c >= 32 ? o31 : 0.f);
            const float qq = (e & 1) ? bfhi(qw[e >> 1]) : bflo(qw[e >> 1]), kk = (e & 1) ? bfhi(kw[e >> 1]) : bflo(kw[e >> 1]);
            qd[e] = qq * 0.0625f * __expf(bc); kd[e] = kk * __expf(-bc); ke[e] = kk * __expf(bl - bc);
            if (c == 63) WSF(WS_GDEC)[(size_t)item * 256 + d] = __expf(bl); }
        u32x4 o; o.x = cvtpk(qd[0], qd[1]); o.y = cvtpk(qd[2], qd[3]); o.z = cvtpk(qd[4], qd[5]); o.w = cvtpk(qd[6], qd[7]); *(LAS u32x4*)(QL + c * 528 + d0 * 2) = o;
        o.x = cvtpk(kd[0], kd[1]); o.y = cvtpk(kd[2], kd[3]); o.z = cvtpk(kd[4], kd[5]); o.w = cvtpk(kd[6], kd[7]); *(LAS u32x4*)(KL + c * 528 + d0 * 2) = o;
        o.x = cvtpk(ke[0], ke[1]); o.y = cvtpk(ke[2], ke[3]); o.z = cvtpk(ke[4], ke[5]); o.w = cvtpk(ke[6], ke[7]); *(u32x4*)(WSB(WS_KEND) + (size_t)(tok0 + c) * 1024 + h * 256 + d0) = o; }
    __syncthreads();
#pragma unroll 1
    for (int it = 0; it < 4; ++it) { const int u = tid + 512 * it, c = u >> 5, pc = u & 31, g32 = pc >> 2, gg = pc & 3;
        const u32x2 lo = *(const LAS u32x2*)(QL + c * 528 + (32 * g32 + 4 * gg) * 2), hi = *(const LAS u32x2*)(QL + c * 528 + (32 * g32 + 16 + 4 * gg) * 2);
        u32x4 o; o.x = lo.x; o.y = lo.y; o.z = hi.x; o.w = hi.y; *(u32x4*)(WSB(WS_QD) + (size_t)(tok0 + c) * 1024 + h * 256 + 8 * pc) = o; }
    { const int ct = w & 3, jp = w >> 2; f32x4 a0 = (f32x4){0.f, 0.f, 0.f, 0.f}, a1 = a0;
#pragma unroll
      for (int s = 0; s < 8; ++s) { const bf16x8 bq = *(const LAS bf16x8*)(QL + (16 * ct + i) * 528 + (32 * s + 8 * g) * 2);
          const bf16x8 k0 = *(const LAS bf16x8*)(KL + (32 * jp + i) * 528 + (32 * s + 8 * g) * 2), k1 = *(const LAS bf16x8*)(KL + (32 * jp + 16 + i) * 528 + (32 * s + 8 * g) * 2);
          a0 = mfma16(k0, bq, a0); a1 = mfma16(k1, bq, a1); }
      const int c = 16 * ct + i;
#pragma unroll
      for (int r = 0; r < 4; ++r) { if (32 * jp + 4 * g + r > c) a0[r] = 0.f; if (32 * jp + 16 + 4 * g + r > c) a1[r] = 0.f; }
      ATT[(ct * 2 + jp) * 64 + lane] = __builtin_bit_cast(u32x4, pack2(a0, a1)); }
    __syncthreads();
    g2l_tile<64, 64>(VL, 1040, (const char*)(WSB(WS_H) + (size_t)tok0 * NP + H_GV + h * 512), (size_t)NP * 2, tid);
    __syncthreads();
    { f32x4 acc[4][4];
#pragma unroll
      for (int et = 0; et < 4; ++et)
#pragma unroll
          for (int ct = 0; ct < 4; ++ct) acc[et][ct] = (f32x4){0.f, 0.f, 0.f, 0.f};
#pragma unroll
      for (int s = 0; s < 2; ++s) { bf16x8 bfr[4];
#pragma unroll
          for (int ct = 0; ct < 4; ++ct) bfr[ct] = __builtin_bit_cast(bf16x8, ATT[(ct * 2 + s) * 64 + lane]);
#pragma unroll
          for (int et = 0; et < 4; ++et) { const bf16x8 a = tr_frag(VL, 1040, 64 * w + 16 * et, 32 * s + 4 * g, 32 * s + 16 + 4 * g, lane);
#pragma unroll
              for (int ct = 0; ct < 4; ++ct) acc[et][ct] = mfma16(a, bfr[ct], acc[et][ct]); } }
#pragma unroll
      for (int et = 0; et < 4; ++et)
#pragma unroll
          for (int ct = 0; ct < 4; ++ct) *(f32x4*)(WSF(WS_GO) + (size_t)(tok0 + 16 * ct + i) * 2048 + h * 512 + 64 * w + 16 * et + 4 * g) = acc[et][ct]; }
    __syncthreads();
}

DI void gla_scan_item(Frame& F, int item) {
    const int es = item & 3, h = (item >> 2) & 3, b = item >> 4;
    int tid = F.tid; asm volatile("" : "+v"(tid)); const int lane = tid & 63, w = __builtin_amdgcn_readfirstlane(tid >> 6); const int i = lane & 15, g = lane >> 4;
    LAS char* QL = (LAS char*)F.lds;
    LAS char* KL = (LAS char*)F.lds + 33792;
    LAS char* VL = (LAS char*)F.lds + 67584;
    LAS float* GD = (LAS float*)(F.lds + 84992);
    f32x4 S[16];
#pragma unroll
    for (int dt = 0; dt < 16; ++dt) S[dt] = (f32x4){0.f, 0.f, 0.f, 0.f};
    u32x4 pq[4], pk[4], pv[2], pg[1];
    const size_t tokb = (size_t)b * SEQ;
    const int ecol = h * 512 + es * 128;
    pf_load<64, 32>(pq, (const char*)(WSB(WS_QD) + tokb * 1024 + h * 256), 2048, tid);
    pf_load<64, 32>(pk, (const char*)(WSB(WS_KEND) + tokb * 1024 + h * 256), 2048, tid);
    pf_load<64, 16>(pv, (const char*)(WSB(WS_H) + tokb * NP + H_GV + ecol), (size_t)NP * 2, tid);
    pf_load<1, 64>(pg, (const char*)(WSF(WS_GDEC) + (size_t)((b * 4 + h) * 128) * 256), 0, tid);
#pragma unroll 1
    for (int n = 0; n < 128; ++n) {
        __syncthreads();
        pf_store<64, 32>(pq, QL, 528, tid); pf_store<64, 32>(pk, KL, 528, tid); pf_store<64, 16>(pv, VL, 272, tid); pf_store<1, 64>(pg, (LAS char*)GD, 0, tid);
        __syncthreads();
        const size_t tok0 = tokb + 64 * n;
        if (n + 1 < 128) { const size_t t1 = tok0 + 64;
            pf_load<64, 32>(pq, (const char*)(WSB(WS_QD) + t1 * 1024 + h * 256), 2048, tid);
            pf_load<64, 32>(pk, (const char*)(WSB(WS_KEND) + t1 * 1024 + h * 256), 2048, tid);
            pf_load<64, 16>(pv, (const char*)(WSB(WS_H) + t1 * NP + H_GV + ecol), (size_t)NP * 2, tid);
            pf_load<1, 64>(pg, (const char*)(WSF(WS_GDEC) + (size_t)((b * 4 + h) * 128 + n + 1) * 256), 0, tid); }
        f32x4 oa[4];
#pragma unroll
        for (int ct = 0; ct < 4; ++ct) oa[ct] = (f32x4){0.f, 0.f, 0.f, 0.f};
#pragma unroll
        for (int s = 0; s < 8; ++s) { const bf16x8 a = pack2(S[2 * s], S[2 * s + 1]);
#pragma unroll
            for (int ct = 0; ct < 4; ++ct) { const bf16x8 bq = *(const LAS bf16x8*)(QL + (16 * ct + i) * 528 + (32 * s + 8 * g) * 2); oa[ct] = mfma16(a, bq, oa[ct]); } }
#pragma unroll
        for (int ct = 0; ct < 4; ++ct) { float* op = WSF(WS_GO) + (tok0 + 16 * ct + i) * 2048 + ecol + 16 * w + 4 * g; const f32x4 o = *(const f32x4*)op; *(f32x4*)op = o + oa[ct]; }
#pragma unroll
        for (int dt = 0; dt < 16; ++dt) { const f32x4 gd = *(const LAS f32x4*)(GD + 16 * dt + 4 * g); S[dt] = S[dt] * gd; }
#pragma unroll
        for (int s = 0; s < 2; ++s) { const bf16x8 bv = tr_frag(VL, 272, 16 * w, 32 * s + 8 * g, 32 * s + 8 * g + 4, lane);
#pragma unroll
            for (int dt = 0; dt < 16; ++dt) { const bf16x8 a = tr_frag(KL, 528, 16 * dt, 32 * s + 8 * g, 32 * s + 8 * g + 4, lane); S[dt] = mfma16(a, bv, S[dt]); } }
    }
    __syncthreads();
}

DI void gla_finalize(Frame& F, const Args& A) {
    const int gw = F.bid * NWAVES + F.wave, NGW = F.G * NWAVES, lane = F.lane;
    const f32x4 g0 = *(const f32x4*)(IN_NORMG(A) + 8 * lane), g1 = *(const f32x4*)(IN_NORMG(A) + 8 * lane + 4);
    for (int idx = gw; idx < M * 4; idx += NGW) { const int tok = idx >> 2, h = idx & 3;
        const float* op = WSF(WS_GO) + (size_t)tok * 2048 + h * 512 + 8 * lane;
        const f32x4 a = *(const f32x4*)op, c = *(const f32x4*)(op + 4);
        float ss = a[0] * a[0] + a[1] * a[1] + a[2] * a[2] + a[3] * a[3] + c[0] * c[0] + c[1] * c[1] + c[2] * c[2] + c[3] * c[3];
        ss = wave_sum(ss);
        const float rs = rsqrtf(ss * (1.f / 512.f) + RMS_EPS);
        const u32x4 z = *(const u32x4*)(WSB(WS_H) + (size_t)tok * NP + H_GZ + h * 512 + 8 * lane);
        u32x4 o;
        o.x = cvtpk(a[0] * rs * g0[0] * siluf_(bflo(z.x)), a[1] * rs * g0[1] * siluf_(bfhi(z.x)));
        o.y = cvtpk(a[2] * rs * g0[2] * siluf_(bflo(z.y)), a[3] * rs * g0[3] * siluf_(bfhi(z.y)));
        o.z = cvtpk(c[0] * rs * g1[0] * siluf_(bflo(z.z)), c[1] * rs * g1[1] * siluf_(bfhi(z.z)));
        o.w = cvtpk(c[2] * rs * g1[2] * siluf_(bflo(z.w)), c[3] * rs * g1[3] * siluf_(bfhi(z.w)));
        *(u32x4*)(WSB(WS_GATED) + (size_t)tok * 2048 + h * 512 + 8 * lane) = o; }
}
DI void qk_tile(f32x4 (&sacc)[4], const LAS char* KL, const bf16x8 (&qf)[4], int i, int grp) {
#pragma unroll
    for (int kt = 0; kt < 4; ++kt) { f32x4 a = (f32x4){0.f, 0.f, 0.f, 0.f};
#pragma unroll
        for (int s = 0; s < 4; ++s) { const bf16x8 ak = *(const LAS bf16x8*)(KL + (16 * kt + i) * 272 + (32 * s + 8 * grp) * 2); a = mfma16(ak, qf[s], a); }
        sacc[kt] = a; }
}
DI void pv_tile(f32x4 (&oacc)[8], const LAS char* VL, const bf16x8 (&pf)[2], int lane, int grp) {
#pragma unroll
    for (int s2 = 0; s2 < 2; ++s2)
#pragma unroll
        for (int dt = 0; dt < 8; ++dt) { const bf16x8 a = tr_frag(VL, 272, 16 * dt, 32 * s2 + 4 * grp, 32 * s2 + 16 + 4 * grp, lane); oacc[dt] = mfma16(a, pf[s2], oacc[dt]); }
}
DI void online_tile(f32x4 (&sacc)[4], unsigned vmask, float& m, float& l, f32x4 (&oacc)[8], const LAS char* VL, int lane, int grp) {
    float tm = NEG;
#pragma unroll
    for (int kt = 0; kt < 4; ++kt)
#pragma unroll
        for (int r = 0; r < 4; ++r) tm = fmaxf(tm, sacc[kt][r]);
    tm = fmaxf(tm, __shfl_xor(tm, 16)); tm = fmaxf(tm, __shfl_xor(tm, 32));
    const float mn = fmaxf(m, tm), alpha = __expf(m - mn);
    float ps = 0.f;
#pragma unroll
    for (int kt = 0; kt < 4; ++kt)
#pragma unroll
        for (int r = 0; r < 4; ++r) { const float p = ((vmask >> (4 * kt + r)) & 1u) ? __expf(sacc[kt][r] - mn) : 0.f; sacc[kt][r] = p; ps += p; }
    l = l * alpha + ps; m = mn;
#pragma unroll
    for (int dt = 0; dt < 8; ++dt) oacc[dt] = oacc[dt] * alpha;
    bf16x8 pf[2]; pf[0] = pack2(sacc[0], sacc[1]); pf[1] = pack2(sacc[2], sacc[3]);
    pv_tile(oacc, VL, pf, lane, grp);
}

DI void nsa_attend_item(Frame& F, int item) {
    const int qt = 255 - (item & 255), g = (item >> 8) & 3, b = item >> 10;
    int tid = F.tid; asm volatile("" : "+v"(tid)); const int lane = tid & 63, w = __builtin_amdgcn_readfirstlane(tid >> 6); const int i = lane & 15, grp = lane >> 4, ql = i >> 2, r4 = i & 3;
    const int t0 = 32 * qt, qi = 4 * w + ql, t = t0 + qi, head = 4 * g + r4;
    const size_t tok = (size_t)b * SEQ + t;
    const float slope = exp2f(-0.5f * (float)(head + 1));
    const float scale = 0.08838834764831845f;
    LAS char* const L0 = (LAS char*)F.lds;
#define NSA_KL(c) (L0 + (c) * 34816)
#define NSA_VL(c) (L0 + (c) * 34816 + 17408)
    LAS float* IMPA = (LAS float*)(F.lds + 69632);
    LAS float* IMPB = (LAS float*)(F.lds + 86016);
    LAS unsigned* SELM = (LAS unsigned*)(F.lds + 102400);
    bf16x8 qf[4];
    { const bf16* qrow = WSB(WS_H) + tok * NP + H_NQ + head * 128;
#pragma unroll
      for (int s = 0; s < 4; ++s) qf[s] = *(const bf16x8*)(qrow + 32 * s + 8 * grp); }
    float gate[3];
#pragma unroll
    for (int br = 0; br < 3; ++br) gate[br] = sigmoidf_(bf2f(WSB(WS_H)[tok * NP + H_SM + 16 + head * 3 + br]));
    f32x4 comb[8], oacc[8], sacc[4];
    u32x4 rk[2], rv[2];
#pragma unroll
    for (int dt = 0; dt < 8; ++dt) comb[dt] = (f32x4){0.f, 0.f, 0.f, 0.f};

    const int cnt_t = t >= 31 ? ((t - 31) >> 4) + 1 : 0;
    const int ntile = (2 * qt + 1 + 63) >> 6;
    const char* kcb = (const char*)(WSB(WS_CMP) + (size_t)((0 * 2 + b) * 4 + g) * 512 * 128);
    const char* vcb = (const char*)(WSB(WS_CMP) + (size_t)((1 * 2 + b) * 4 + g) * 512 * 128);
    pf_load<64, 16>(rk, kcb, 256, tid);
    for (int u = tid; u < 8192; u += 512) IMPA[u] = 0.f;
    pf_store<64, 16>(rk, NSA_KL(0), 272, tid);
    __syncthreads();
    float m = NEG, l = 0.f;
#pragma unroll 1
    for (int T = 0; T < ntile; ++T) { const int cb = T & 1; const bool hn = T + 1 < ntile;
        if (hn) pf_load<64, 16>(rk, kcb + (size_t)(T + 1) * 64 * 256, 256, tid);
        qk_tile(sacc, NSA_KL(cb), qf, i, grp);
        float tm = NEG;
#pragma unroll
        for (int kt = 0; kt < 4; ++kt)
#pragma unroll
            for (int r = 0; r < 4; ++r) { const int n = 64 * T + 16 * kt + 4 * grp + r; const float s = n < cnt_t ? sacc[kt][r] * scale - slope * (float)(t - (16 * n + 31)) : NEG; sacc[kt][r] = s; tm = fmaxf(tm, s); }
        tm = fmaxf(tm, __shfl_xor(tm, 16)); tm = fmaxf(tm, __shfl_xor(tm, 32));
        const float mn = fmaxf(m, tm); float ps = 0.f;
#pragma unroll
        for (int kt = 0; kt < 4; ++kt)
#pragma unroll
            for (int r = 0; r < 4; ++r) { const int n = 64 * T + 16 * kt + 4 * grp + r; ps += n < cnt_t ? __expf(sacc[kt][r] - mn) : 0.f; }
        l = l * __expf(m - mn) + ps; m = mn;
        if (hn) pf_store<64, 16>(rk, NSA_KL(cb ^ 1), 272, tid);
        __syncthreads();
    }
    l += __shfl_xor(l, 16); l += __shfl_xor(l, 32);
    const float inv = (cnt_t > 0 && l > 0.f) ? 1.f / l : 0.f;
#pragma unroll
    for (int dt = 0; dt < 8; ++dt) oacc[dt] = (f32x4){0.f, 0.f, 0.f, 0.f};
    pf_load<64, 16>(rk, kcb, 256, tid); pf_load<64, 16>(rv, vcb, 256, tid);
    pf_store<64, 16>(rk, NSA_KL(0), 272, tid); pf_store<64, 16>(rv, NSA_VL(0), 272, tid);
    __syncthreads();
#pragma unroll 1
    for (int T = 0; T < ntile; ++T) { const int cb = T & 1; const bool hn = T + 1 < ntile;
        if (hn) { pf_load<64, 16>(rk, kcb + (size_t)(T + 1) * 64 * 256, 256, tid); pf_load<64, 16>(rv, vcb + (size_t)(T + 1) * 64 * 256, 256, tid); }
        qk_tile(sacc, NSA_KL(cb), qf, i, grp);
#pragma unroll
        for (int kt = 0; kt < 4; ++kt) {
#pragma unroll
            for (int r = 0; r < 4; ++r) { const int n = 64 * T + 16 * kt + 4 * grp + r; sacc[kt][r] = n < cnt_t ? __expf(sacc[kt][r] * scale - slope * (float)(t - (16 * n + 31)) - m) * inv : 0.f; }
            f32x4 ps = sacc[kt];
#pragma unroll
            for (int r = 0; r < 4; ++r) { ps[r] += __shfl_xor(ps[r], 1); ps[r] += __shfl_xor(ps[r], 2); }
            const int j = 16 * T + 4 * kt + grp;
            if (r4 == 0) { IMPA[qi * 128 + j] = (ps[0] + ps[1]) + (ps[2] + ps[3]); if (j + 1 < 128) IMPB[qi * 128 + j + 1] = ps[3]; }
        }
        bf16x8 pf[2]; pf[0] = pack2(sacc[0], sacc[1]); pf[1] = pack2(sacc[2], sacc[3]);
        pv_tile(oacc, NSA_VL(cb), pf, lane, grp);
        if (hn) { pf_store<64, 16>(rk, NSA_KL(cb ^ 1), 272, tid); pf_store<64, 16>(rv, NSA_VL(cb ^ 1), 272, tid); }
        __syncthreads();
    }
#pragma unroll
    for (int dt = 0; dt < 8; ++dt) comb[dt] = comb[dt] + oacc[dt] * gate[0];

    const int cur = t0 >> 6;
    const char* const hb = (const char*)(WSB(WS_H) + (size_t)b * SEQ * NP + g * 128);
    const int jlo = t0 >= 511 ? (t0 - 511) >> 6 : 0;
#pragma unroll 1
    for (int qq = 0; qq < 4; ++qq) { const int q = 4 * w + qq; const int j0 = lane, j1 = lane + 64;
        float v0 = (j0 == 0 || j0 == cur || j0 == cur - 1) ? 1e4f : (j0 <= cur ? IMPA[q * 128 + j0] + IMPB[q * 128 + j0] : -1.f);
        float v1 = (j1 == cur || j1 == cur - 1) ? 1e4f : (j1 <= cur ? IMPA[q * 128 + j1] + IMPB[q * 128 + j1] : -1.f);
        bool s0 = false, s1 = false;
#pragma unroll 1
        for (int round = 0; round < 16; ++round) { float bv = v0; int bi = j0; if (v1 > v0) { bv = v1; bi = j1; }
#pragma unroll
            for (int off = 32; off >= 1; off >>= 1) { const float ov = __shfl_xor(bv, off); const int oi = __shfl_xor(bi, off); if (ov > bv || (ov == bv && oi < bi)) { bv = ov; bi = oi; } }
            if (bi == j0) { v0 = -2.f; s0 = true; } if (bi == j1) { v1 = -2.f; s1 = true; } }
        const unsigned long long b0 = __ballot(s0), b1 = __ballot(s1);
        if (lane == 0) { SELM[q * 4 + 0] = (unsigned)b0; SELM[q * 4 + 1] = (unsigned)(b0 >> 32); SELM[q * 4 + 2] = (unsigned)b1; SELM[q * 4 + 3] = (unsigned)(b1 >> 32); } }
    __syncthreads();
    unsigned u0 = 0u, u1 = 0u, u2 = 0u, u3 = 0u;
    for (int q = 0; q < 32; ++q) { u0 |= SELM[q * 4 + 0]; u1 |= SELM[q * 4 + 1]; u2 |= SELM[q * 4 + 2]; u3 |= SELM[q * 4 + 3]; }
    const unsigned mm0 = SELM[qi * 4 + 0], mm1 = SELM[qi * 4 + 1], mm2 = SELM[qi * 4 + 2], mm3 = SELM[qi * 4 + 3];
    u0 = __builtin_amdgcn_readfirstlane(u0 & (cur >= 31 ? 0xffffffffu : ((2u << cur) - 1u)));
    u1 = __builtin_amdgcn_readfirstlane(u1 & (cur >= 63 ? 0xffffffffu : (cur < 32 ? 0u : ((2u << (cur - 32)) - 1u))));
    u2 = __builtin_amdgcn_readfirstlane(u2 & (cur >= 95 ? 0xffffffffu : (cur < 64 ? 0u : ((2u << (cur - 64)) - 1u))));
    u3 = __builtin_amdgcn_readfirstlane(u3 & (cur >= 127 ? 0xffffffffu : (cur < 96 ? 0u : ((2u << (cur - 96)) - 1u))));

    m = NEG; l = 0.f;
#pragma unroll
    for (int dt = 0; dt < 8; ++dt) oacc[dt] = (f32x4){0.f, 0.f, 0.f, 0.f};
    LAS int* LIST = (LAS int*)(F.lds + 102912);
    if (tid < 128) { const int p = tid; const unsigned wv = p < 32 ? u0 : (p < 64 ? u1 : (p < 96 ? u2 : u3));
        if ((wv >> (p & 31)) & 1u) { int idx = __popc(wv & ((1u << (p & 31)) - 1u)); if (p >= 32) idx += __popc(u0); if (p >= 64) idx += __popc(u1); if (p >= 96) idx += __popc(u2); LIST[idx] = p; } }
    const int nblk = __popc(u0) + __popc(u1) + __popc(u2) + __popc(u3);
    __syncthreads();
    { int j = __builtin_amdgcn_readfirstlane(LIST[0]);
      { const char* kb = hb + (size_t)(64 * j) * NP * 2 + H_NKS * 2;
          pf_load<64, 16>(rk, kb, (size_t)NP * 2, tid); pf_load<64, 16>(rv, kb + (H_NVS - H_NKS) * 2, (size_t)NP * 2, tid);
          pf_store<64, 16>(rk, NSA_KL(0), 272, tid); pf_store<64, 16>(rv, NSA_VL(0), 272, tid); }
      __syncthreads();
#pragma unroll 1
      for (int it = 0; it < nblk; ++it) { const int cb = it & 1; const bool hn = it + 1 < nblk; const int jn = hn ? __builtin_amdgcn_readfirstlane(LIST[it + 1]) : 0;
          if (hn) { const char* kb = hb + (size_t)(64 * jn) * NP * 2 + H_NKS * 2;
              pf_load<64, 16>(rk, kb, (size_t)NP * 2, tid); pf_load<64, 16>(rv, kb + (H_NVS - H_NKS) * 2, (size_t)NP * 2, tid); }
          qk_tile(sacc, NSA_KL(cb), qf, i, grp);
          const unsigned mw = j < 32 ? mm0 : (j < 64 ? mm1 : (j < 96 ? mm2 : mm3));
          const bool sel = (mw >> (j & 31)) & 1u; unsigned vmask = 0u;
#pragma unroll
          for (int kt = 0; kt < 4; ++kt)
#pragma unroll
              for (int r = 0; r < 4; ++r) { const int pos = 64 * j + 16 * kt + 4 * grp + r; const bool ok = sel && pos <= t;
                  sacc[kt][r] = ok ? sacc[kt][r] * scale - slope * (float)(t - pos) : NEG; vmask |= ok ? (1u << (4 * kt + r)) : 0u; }
          online_tile(sacc, vmask, m, l, oacc, NSA_VL(cb), lane, grp);
          if (hn) { pf_store<64, 16>(rk, NSA_KL(cb ^ 1), 272, tid); pf_store<64, 16>(rv, NSA_VL(cb ^ 1), 272, tid); }
          __syncthreads();
          j = jn; } }
    l += __shfl_xor(l, 16); l += __shfl_xor(l, 32);
    { const float il = l > 0.f ? gate[1] / l : 0.f;
#pragma unroll
      for (int dt = 0; dt < 8; ++dt) comb[dt] = comb[dt] + oacc[dt] * il; }

    m = NEG; l = 0.f;
#pragma unroll
    for (int dt = 0; dt < 8; ++dt) oacc[dt] = (f32x4){0.f, 0.f, 0.f, 0.f};
    { const char* kb = hb + (size_t)(64 * jlo) * NP * 2 + H_NKW * 2;
      pf_load<64, 16>(rk, kb, (size_t)NP * 2, tid); pf_load<64, 16>(rv, kb + (H_NVW - H_NKW) * 2, (size_t)NP * 2, tid);
      pf_store<64, 16>(rk, NSA_KL(0), 272, tid); pf_store<64, 16>(rv, NSA_VL(0), 272, tid); }
    __syncthreads();
#pragma unroll 1
    for (int j = jlo; j <= cur; ++j) { const int cb = (j - jlo) & 1; const bool hn = j + 1 <= cur;
        if (hn) { const char* kb = hb + (size_t)(64 * (j + 1)) * NP * 2 + H_NKW * 2;
            pf_load<64, 16>(rk, kb, (size_t)NP * 2, tid); pf_load<64, 16>(rv, kb + (H_NVW - H_NKW) * 2, (size_t)NP * 2, tid); }
        qk_tile(sacc, NSA_KL(cb), qf, i, grp);
        unsigned vmask = 0u;
#pragma unroll
        for (int kt = 0; kt < 4; ++kt)
#pragma unroll
            for (int r = 0; r < 4; ++r) { const int pos = 64 * j + 16 * kt + 4 * grp + r; const int dist = t - pos; const bool ok = dist >= 0 && dist < 512;
                sacc[kt][r] = ok ? sacc[kt][r] * scale - slope * (float)dist : NEG; vmask |= ok ? (1u << (4 * kt + r)) : 0u; }
        online_tile(sacc, vmask, m, l, oacc, NSA_VL(cb), lane, grp);
        if (hn) { pf_store<64, 16>(rk, NSA_KL(cb ^ 1), 272, tid); pf_store<64, 16>(rv, NSA_VL(cb ^ 1), 272, tid); }
        __syncthreads();
    }
    l += __shfl_xor(l, 16); l += __shfl_xor(l, 32);
    { const float il = l > 0.f ? gate[2] / l : 0.f;
#pragma unroll
      for (int dt = 0; dt < 8; ++dt) comb[dt] = comb[dt] + oacc[dt] * il; }

    { const bf16* zrow = WSB(WS_H) + tok * NP + H_NZ + head * 128; bf16* orow = WSB(WS_GATED) + (size_t)1 * M * 2048 + tok * 2048 + head * 128;
#pragma unroll
      for (int dt = 0; dt < 8; ++dt) { const int d0 = 16 * dt + 4 * grp; const u32x2 z = *(const u32x2*)(zrow + d0);
          u32x2 o; o.x = cvtpk(comb[dt][0] * siluf_(bflo(z.x)), comb[dt][1] * siluf_(bfhi(z.x))); o.y = cvtpk(comb[dt][2] * siluf_(bflo(z.y)), comb[dt][3] * siluf_(bfhi(z.y)));
          *(u32x2*)(orow + d0) = o; } }
#undef NSA_KL
#undef NSA_VL
}
DI void ln_rows(Frame& F, const Args& A) {
    const int gw = F.bid * NWAVES + F.wave, NGW = F.G * NWAVES, lane = F.lane;
    for (int row = gw; row < M; row += NGW) {
        f32x4* rp = (f32x4*)(A.out + (size_t)row * DM) + lane;
        f32x4 v[16]; float s = 0.f;
#pragma unroll
        for (int j = 0; j < 16; ++j) { v[j] = rp[64 * j]; s += (v[j][0] + v[j][1]) + (v[j][2] + v[j][3]); }
        const float mean = wave_sum(s) * (1.f / DM); float q = 0.f;
#pragma unroll
        for (int j = 0; j < 16; ++j) { v[j] = v[j] - mean; q += (v[j][0] * v[j][0] + v[j][1] * v[j][1]) + (v[j][2] * v[j][2] + v[j][3] * v[j][3]); }
        const float rstd = rsqrtf(wave_sum(q) * (1.f / DM) + LN_EPS);
#pragma unroll
        for (int j = 0; j < 16; ++j) { const f32x4 gg = ((const f32x4*)IN_LNG(A))[lane + 64 * j], bb = ((const f32x4*)IN_LNB(A))[lane + 64 * j]; rp[64 * j] = v[j] * rstd * gg + bb; }
    }
}

constexpr int N_PHASES = 8;
__global__ void __launch_bounds__(NWAVES * 64, 2) mk_fwd(Args args) {
    extern __shared__ __attribute__((aligned(16))) unsigned char lds_raw[];
    Frame F;
    F.lds = (LAS unsigned char*)lds_raw;
    F.MISC = (volatile LAS unsigned*)(F.lds + MISC_OFF);
    F.tid = threadIdx.x; F.lane = F.tid & 63; F.wave = __builtin_amdgcn_readfirstlane(F.tid >> 6);
    F.G = gridDim.x; F.bid = blockIdx.x;
    F.ws = args.ws;
    F.ctl = (gu32*)(F.ws + WS_CTL);
    for (int u = F.tid; u < 64; u += NWAVES * 64) ((LAS unsigned*)(F.lds + MISC_OFF))[u] = 0u;
    __syncthreads();
    const int lo = args.ph_lo, hi = args.ph_hi;
    XcdBarrier bar; bar.bar = (unsigned*)(F.ctl + CW_BAR); bar.x = 0; bar.st = nullptr;
    if (hi - lo > 1) bar = xcd_barrier_post((unsigned*)(F.ctl + CW_BAR), F.MISC + 8);
#ifndef MK_PHASE_MASK
#define MK_PHASE_MASK 0xFF
#endif
#define IN(k) (((MK_PHASE_MASK >> (k)) & 1) && lo <= (k) && (k) < hi)
#define SEAM(k) do { if (IN(k) && IN((k) + 1)) xcd_barrier(bar); } while (0)

    if (IN(0)) { p0_prologue(F, args); }
    SEAM(0);
    if (IN(1)) {
        pg8::Gemm gm{WSB(WS_XB), WSB(WS_WINT), M + 512, NP + 4096, 4096}; pg8::H1Order S; S.init(F.G, F.bid); pg8::EpiH1 E{WSB(WS_H), NP, WSB(WS_KVMEM), 4096};
        pg8::gemm_phase<pg8::EpiH1, pg8::H1Order, true, true>(F.lds, gm, S, E);
    }
    SEAM(1);
    if (IN(2)) {
        for (;;) { const int it = wq_next(F, CW_Q2); if (it >= 64 + 512 + 1024) break;

#ifndef MK_NO_CMP
            if (it < 64) compress_item(F, it);
#endif
#ifndef MK_NO_MEM
            if (it >= 64 && it < 576) mem_attn_item(F, it - 64);
#endif
#ifndef MK_NO_PREP
            if (it >= 576) gla_prep_item(F, args, it - 576);
#endif
        }
    }
    SEAM(2);
    if (IN(3)) {
        for (;;) { const int it = wq_next(F, CW_Q3);
#ifdef MK_PROBE_ATT
            if (it >= 32 + 4096) break;
#else
            if (it >= 32 + 2048) break;
#endif


#ifndef MK_NO_SCAN
            if (it < 32) gla_scan_item(F, it);
#endif
#ifndef MK_NO_ATT
            if (it >= 32) nsa_attend_item(F, (it - 32) & 2047);
#endif
        }
    }
    SEAM(3);
    if (IN(4)) { gla_finalize(F, args); }
    SEAM(4);
    if (IN(5)) {
        pg8::Gemm gm{WSB(WS_GATED), WSB(WS_WBRT), 3 * M, 3 * 4096, 2048}; pg8::MergeOrder S; S.init(F.G, F.bid); pg8::EpiMerge E{WSB(WS_H), NP, H_MRG, IN_BMERGE(args), WSB(WS_MERGED)};
        pg8::gemm_phase<pg8::EpiMerge, pg8::MergeOrder, true, true>(F.lds, gm, S, E);
    }
    SEAM(5);
    if (IN(6)) {
        pg8::Gemm gm{WSB(WS_MERGED), WSB(WS_WOUTT), M, 4096, 4096}; pg8::StaticOrder S; S.init(M, 4096, F.G, F.bid); pg8::EpiOut E{IN_X(args), args.out, ALPHA};
        pg8::gemm_phase<pg8::EpiOut, pg8::StaticOrder, true, true>(F.lds, gm, S, E);
    }
    SEAM(6);
    if (IN(7)) { ln_rows(F, args); }
#undef IN
#undef SEAM
}

extern "C" void kernel_launch(void* const* d_in, const int* in_sizes, int n_in, void* d_out, int out_size, void* d_ws, size_t ws_size, hipStream_t stream) {
    static int grid = 0;
    if (grid == 0) {
        if (n_in != 20 || in_sizes[0] != M * DM || out_size != M * DM || ws_size < WS_END) { fprintf(stderr, "kernel_launch: unexpected problem (n_in %d in0 %d out %d ws %zu); nothing launched\n", n_in, n_in > 0 ? in_sizes[0] : -1, out_size, ws_size); grid = -1; return; }
        int dev = 0, cus = 0, per_cu = 0;
        if (hipGetDevice(&dev) != hipSuccess || hipDeviceGetAttribute(&cus, hipDeviceAttributeMultiprocessorCount, dev) != hipSuccess) { grid = -1; return; }
        if (hipFuncSetAttribute((const void*)mk_fwd, hipFuncAttributeMaxDynamicSharedMemorySize, LDS_BYTES) != hipSuccess) { fprintf(stderr, "kernel_launch: hipFuncSetAttribute failed\n"); grid = -1; return; }
        if (hipOccupancyMaxActiveBlocksPerMultiprocessor(&per_cu, (const void*)mk_fwd, NWAVES * 64, LDS_BYTES) != hipSuccess || per_cu < 1) { fprintf(stderr, "kernel_launch: occupancy query reports %d blocks per CU\n", per_cu); (void)hipGetLastError(); grid = -1; return; }
        grid = cus;
    }
    if (grid < 0) return;
    if (hipMemsetAsync((char*)d_ws + WS_CTL, 0, CTL_ZERO_BYTES, stream) != hipSuccess) return;
    Args a{};
    for (int i = 0; i < 20; ++i) a.in[i] = (const float*)d_in[i];
    a.out = (float*)d_out; a.ws = (unsigned char*)d_ws;
#if MK_SINGLE
    a.ph_lo = 0; a.ph_hi = N_PHASES;
    hipLaunchKernelGGL(mk_fwd, dim3(grid), dim3(NWAVES * 64), LDS_BYTES, stream, a);
#else
    for (int p = 0; p < N_PHASES; ++p) { a.ph_lo = p; a.ph_hi = p + 1; hipLaunchKernelGGL(mk_fwd, dim3(grid), dim3(NWAVES * 64), LDS_BYTES, stream, a);
#ifdef MK_PROBE
        if (p == MK_PROBE) { (void)hipMemsetAsync((char*)d_ws + WS_CTL, 0, CTL_ZERO_BYTES, stream);
            if (MK_PROBE == 3) { a.ph_lo = 2; a.ph_hi = 3; hipLaunchKernelGGL(mk_fwd, dim3(grid), dim3(NWAVES * 64), LDS_BYTES, stream, a); a.ph_lo = 3; a.ph_hi = 4; }
            hipLaunchKernelGGL(mk_fwd, dim3(grid), dim3(NWAVES * 64), LDS_BYTES, stream, a); }
#endif
    }
#endif
}
```

```cpp
#include <hip/hip_runtime.h>
#include <cstdio>
#include <cstdint>

#ifndef MK_SINGLE
#define MK_SINGLE 1
#endif

#define DI __device__ __forceinline__
#define LAS __attribute__((address_space(3)))
#define GAS __attribute__((address_space(1)))
typedef unsigned short bf16;
typedef short bf16x8 __attribute__((ext_vector_type(8)));
typedef short s16x4 __attribute__((ext_vector_type(4)));
typedef short v4i16_t __attribute__((ext_vector_type(4)));
typedef float f32x4 __attribute__((ext_vector_type(4)));
typedef float f32x2_t __attribute__((ext_vector_type(2)));
typedef __bf16 bf16x2_t __attribute__((ext_vector_type(2)));
typedef unsigned u32x4 __attribute__((ext_vector_type(4)));
typedef unsigned u32x2 __attribute__((ext_vector_type(2)));
typedef GAS unsigned gu32;
#define RLX_AGENT __ATOMIC_RELAXED, __HIP_MEMORY_SCOPE_AGENT

constexpr int DM = 4096, BATCH = 2, SEQ = 8192, M = BATCH * SEQ;
constexpr int D_IN = 29760;
constexpr int NP = 29952;
constexpr int H_GQ = 0, H_GK = 1024, H_GV = 2048, H_GZ = 4096, H_NQ = 6144, H_NKC = 8192, H_NVC = 8704, H_NKS = 9216, H_NVS = 9728,
              H_NKW = 10240, H_NVW = 10752, H_NZ = 11264, H_MQ = 13312, H_MZ = 15360, H_MRG = 17408, H_SM = 29696;
constexpr float ALPHA = 1.189207115002721f;
constexpr float LN_EPS = 1e-5f, RMS_EPS = 1e-6f;
constexpr float NEG = -1e30f;

__host__ __device__ __forceinline__ int win_src_col(int n) {
    if (n < 6144) return n;
    if (n < 13312) return n + 16;
    if (n < 29696) return n + 64;
    if (n < 29712) return n - 29696 + 6144;
    if (n < 29760) return n - 29712 + 13328;
    return -1;
}

constexpr size_t MiB = 1u << 20;
constexpr size_t WS_CTL = 0, CTL_ZERO_BYTES = 64 * 1024;
constexpr size_t WS_C1 = 512 * 1024;
constexpr size_t WS_WINT = 2 * MiB;
constexpr size_t WS_WKVT = 236 * MiB;
constexpr size_t WS_XB = 268 * MiB;
constexpr size_t WS_MEMB = 396 * MiB;
constexpr size_t WS_H = 400 * MiB;
constexpr size_t WS_KVMEM = 1336 * MiB;
constexpr size_t WS_WBRT = 1340 * MiB;
constexpr size_t WS_WOUTT = 1388 * MiB;
constexpr size_t WS_W1T = 1420 * MiB;
constexpr size_t WS_W2T = 1422 * MiB;
constexpr size_t WS_CMP = 1423 * MiB;
constexpr size_t WS_GDEC = 1425 * MiB;
constexpr size_t WS_QD = 1426 * MiB;
constexpr size_t WS_KEND = 1458 * MiB;
constexpr size_t WS_MERGED = 1490 * MiB;
constexpr size_t WS_GO2 = 1618 * MiB;
constexpr size_t WS_END = 1746 * MiB;
constexpr size_t WS_GATED = 2 * MiB;
constexpr size_t WS_GO = 268 * MiB;
static_assert(WS_GATED + 3 * (size_t)M * 2048 * 2 <= WS_WKVT && WS_GO + (size_t)M * 2048 * 4 <= WS_MEMB, "overlays");
static_assert(WS_WINT + (size_t)NP * 4096 * 2 == WS_WKVT && WS_XB + (size_t)M * 4096 * 2 == WS_MEMB, "P1 treats [xb ; memb] and [w_in_t ; w_kv_t] as single matrices");
constexpr int CW_Q2 = 64, CW_Q3 = 128;
constexpr int CW_BAR = 4096;

constexpr int LDS_BYTES = 155648;
constexpr int MISC_OFF = LDS_BYTES - 256;
constexpr int NWAVES = 8;

DI float bflo(unsigned w) { return __uint_as_float(w << 16); }
DI float bfhi(unsigned w) { return __uint_as_float(w & 0xffff0000u); }
DI float bf2f(bf16 b) { return __uint_as_float(((unsigned)b) << 16); }
DI unsigned cvtpk(float lo, float hi) { f32x2_t v = {lo, hi}; bf16x2_t b = __builtin_convertvector(v, bf16x2_t); return __builtin_bit_cast(unsigned, b); }
DI f32x4 mfma16(bf16x8 a, bf16x8 b, f32x4 c) { return __builtin_amdgcn_mfma_f32_16x16x32_bf16(a, b, c, 0, 0, 0); }
DI bf16x8 pack2(f32x4 a, f32x4 b) { u32x4 p; p.x = cvtpk(a[0], a[1]); p.y = cvtpk(a[2], a[3]); p.z = cvtpk(b[0], b[1]); p.w = cvtpk(b[2], b[3]); return __builtin_bit_cast(bf16x8, p); }
DI s16x4 trread(const LAS char* p) { return __builtin_bit_cast(s16x4, __builtin_amdgcn_ds_read_tr16_b64_v4i16((LAS v4i16_t*)p)); }
DI bf16x8 tr_frag(const LAS char* img, int RS, int m0, int kA, int kB, int lane) {
    const int q = (lane & 15) >> 2, p = lane & 3;
    const s16x4 lo = trread(img + (kA + q) * RS + (m0 + 4 * p) * 2);
    const s16x4 hi = trread(img + (kB + q) * RS + (m0 + 4 * p) * 2);
    return __builtin_shufflevector(lo, hi, 0, 1, 2, 3, 4, 5, 6, 7);
}
DI float wave_sum(float v) {
#pragma unroll
    for (int o = 1; o < 64; o <<= 1) v += __shfl_xor(v, o);
    return v;
}
DI void lds_barrier() { asm volatile("s_waitcnt lgkmcnt(0)" ::: "memory"); __builtin_amdgcn_s_barrier(); asm volatile("" ::: "memory"); }
DI float sigmoidf_(float x) { return 1.f / (1.f + __expf(-x)); }
DI float siluf_(float x) { return x / (1.f + __expf(-x)); }
template <int ROWS, int CHUNKS> DI void g2l_tile(LAS char* dst, int dstRS, const char* src, size_t srcRS, int tid) {
#pragma unroll
    for (int it = 0; it < (ROWS * CHUNKS + 511) / 512; ++it) { const int idx = tid + it * 512;
        if ((ROWS * CHUNKS) % 512 == 0 || idx < ROWS * CHUNKS) { const int r = idx / CHUNKS, c = idx % CHUNKS;
            *(LAS u32x4*)(dst + r * dstRS + c * 16) = *(const u32x4*)(src + (size_t)r * srcRS + c * 16); } }
}
template <int ROWS, int CHUNKS> DI void pf_load(u32x4 (&v)[(ROWS * CHUNKS + 511) / 512], const char* src, size_t srcRS, int tid) {
#pragma unroll
    for (int it = 0; it < (ROWS * CHUNKS + 511) / 512; ++it) { const int idx = tid + it * 512;
        if ((ROWS * CHUNKS) % 512 == 0 || idx < ROWS * CHUNKS) { const int r = idx / CHUNKS, c = idx % CHUNKS; v[it] = *(const u32x4*)(src + (size_t)r * srcRS + c * 16); } }
}
template <int ROWS, int CHUNKS> DI void pf_store(const u32x4 (&v)[(ROWS * CHUNKS + 511) / 512], LAS char* dst, int dstRS, int tid) {
#pragma unroll
    for (int it = 0; it < (ROWS * CHUNKS + 511) / 512; ++it) { const int idx = tid + it * 512;
        if ((ROWS * CHUNKS) % 512 == 0 || idx < ROWS * CHUNKS) { const int r = idx / CHUNKS, c = idx % CHUNKS; *(LAS u32x4*)(dst + r * dstRS + c * 16) = v[it]; } }
}
namespace pg8 {
#define PG8_LAS __attribute__((address_space(3)))
typedef unsigned short bf16_t;
typedef short bf16x8 __attribute__((ext_vector_type(8)));
typedef float f32x4 __attribute__((ext_vector_type(4)));
typedef unsigned u32x4 __attribute__((ext_vector_type(4)));
constexpr int BM = 256, BK = 64, HALF = 128, HTB = HALF * BK * 2  , STAGE_BYTES = 8 * HTB, NXCD = 8, WGM = 8;

__host__ __device__ __forceinline__ int lds_byte(int r, int c) { const int st = (r >> 4) * 2 + (c >> 5), rr = r & 15, cc = c & 31, ob = rr * 64 + cc * 2; return st * 1024 + (ob ^ (((ob >> 9) & 1) << 5)); }
__host__ __device__ __forceinline__ void stage_rc(int b, int& R, int& C) { const int st = b / 1024, sb = b % 1024, swz = sb ^ (((sb >> 9) & 1) << 5); R = (st >> 1) * 16 + swz / 64; C = (st & 1) * 32 + (swz % 64) / 2; }
__host__ __device__ __forceinline__ int perm32(int rho) { const int n = rho >> 4, i = rho & 15; return 8 * (i >> 2) + 4 * n + (i & 3); }

struct Unit { int pm, pn; };
struct Gemm { const bf16_t* A; const bf16_t* Bt; int M, N, K; };

struct StaticOrder {
    int nM, nN, nwg, G, c;
    __host__ __device__ void init(int M, int N, int G_, int c_) { nM = M / BM; nN = N / BM; nwg = nM * nN; G = G_; c = c_; }
    __host__ __device__ bool next(int i, Unit& u) const {
        const long L = (long)i * G + c; if (L >= nwg) return false;
        int wgid = (int)L; { const int q = nwg / NXCD, r = nwg % NXCD, xcd = wgid % NXCD, off = wgid / NXCD; wgid = (xcd < r ? xcd * (q + 1) : r * (q + 1) + (xcd - r) * q) + off; }
        const int nig = WGM * nN, gid = wgid / nig, fm = gid * WGM, gsz = (nM - fm) < WGM ? (nM - fm) : WGM;
        u.pm = fm + ((wgid % nig) % gsz); u.pn = (wgid % nig) / gsz; return true;
    }
    __device__ __forceinline__ void a_ready(const Unit&) const {}
    __device__ __forceinline__ void done(const Unit&) const {}
};

__device__ __forceinline__ unsigned cvt_pk_bf16(float lo, float hi) { unsigned r; asm volatile("v_cvt_pk_bf16_f32 %0, %1, %2" : "=v"(r) : "v"(lo), "v"(hi)); return r; }
typedef float f32x2 __attribute__((ext_vector_type(2)));
struct EpiStore {
    static constexpr bool PERM = true, AFTER_DRAIN = false, RW = false;
    bf16_t* O; int ldc;
    __device__ __forceinline__ void operator()(const f32x4 (&acc)[2][2][4][2], const Unit& u, int wr, int wc, int fr, int fq) const {
        const int row0 = u.pm * BM + wr * 64 + fr, col0 = u.pn * BM + wc * 32 + 8 * fq;
#pragma unroll
        for (int ai = 0; ai < 2; ++ai)
#pragma unroll
            for (int m = 0; m < 4; ++m) { bf16_t* rowp = O + (size_t)(row0 + ai * HALF + m * 16) * ldc + col0;
#pragma unroll
                for (int bj = 0; bj < 2; ++bj) { const f32x4 v0 = acc[ai][bj][m][0], v1 = acc[ai][bj][m][1];
                    u32x4 w; w.x = cvt_pk_bf16(v0[0], v0[1]); w.y = cvt_pk_bf16(v0[2], v0[3]); w.z = cvt_pk_bf16(v1[0], v1[1]); w.w = cvt_pk_bf16(v1[2], v1[3]);
                    *(u32x4*)(rowp + bj * HALF) = w; } }
    }
};
struct EpiMerge {
    static constexpr bool PERM = true, AFTER_DRAIN = false, RW = true;
    const bf16_t* Hh; int ldh, mrg_col; const float* bmerge; bf16_t* MG;
    __device__ __forceinline__ bool rw(f32x4 (&acc)[2][2][4][2], const Unit& u, int wr, int wc, int fr, int fq) const {
        const int br = u.pm >> 6, pm = u.pm & 63, pn = u.pn & 15;
        const int row0 = pm * BM + wr * 64 + fr, col0 = pn * BM + wc * 32 + 8 * fq;
        const bool last = br == 2; const int brn = last ? 2 : br + 1;
#pragma unroll
        for (int bj = 0; bj < 2; ++bj) { const int col = col0 + bj * HALF;
            const f32x4 bd0 = *(const f32x4*)(bmerge + br * 4096 + col), bd1 = *(const f32x4*)(bmerge + br * 4096 + col + 4);
            const f32x4 bn0 = *(const f32x4*)(bmerge + brn * 4096 + col), bn1 = *(const f32x4*)(bmerge + brn * 4096 + col + 4);
#pragma unroll
            for (int ai = 0; ai < 2; ++ai)
#pragma unroll
                for (int m = 0; m < 4; ++m) { const int row = row0 + ai * HALF + m * 16;
                    const bf16_t* hp = Hh + (size_t)row * ldh + mrg_col + col;
                    const u32x4 gd = *(const u32x4*)(hp + br * 4096), gn = *(const u32x4*)(hp + brn * 4096);
                    const unsigned dw[4] = {gd.x, gd.y, gd.z, gd.w}, nw[4] = {gn.x, gn.y, gn.z, gn.w};
                    f32x4 f0, f1;
#pragma unroll
                    for (int j = 0; j < 4; ++j) {
                        const float d0 = ((j & 1) ? __uint_as_float(dw[j >> 1] & 0xffff0000u) : __uint_as_float(dw[j >> 1] << 16)) + bd0[j];
                        const float d1 = ((j & 1) ? __uint_as_float(dw[2 + (j >> 1)] & 0xffff0000u) : __uint_as_float(dw[2 + (j >> 1)] << 16)) + bd1[j];
                        const float n0 = ((j & 1) ? __uint_as_float(nw[j >> 1] & 0xffff0000u) : __uint_as_float(nw[j >> 1] << 16)) + bn0[j];
                        const float n1 = ((j & 1) ? __uint_as_float(nw[2 + (j >> 1)] & 0xffff0000u) : __uint_as_float(nw[2 + (j >> 1)] << 16)) + bn1[j];
                        const float num0 = last ? 1.f : 1.f + __expf(-n0), num1 = last ? 1.f : 1.f + __expf(-n1);
                        f0[j] = num0 / (1.f + __expf(-d0)); f1[j] = num1 / (1.f + __expf(-d1)); }
                    const f32x4 v0 = acc[ai][bj][m][0] * f0, v1 = acc[ai][bj][m][1] * f1;
                    acc[ai][bj][m][0] = v0; acc[ai][bj][m][1] = v1;
                    if (last) { u32x4 w; w.x = cvt_pk_bf16(v0[0], v0[1]); w.y = cvt_pk_bf16(v0[2], v0[3]); w.z = cvt_pk_bf16(v1[0], v1[1]); w.w = cvt_pk_bf16(v1[2], v1[3]);
                        *(u32x4*)(MG + (size_t)row * 4096 + col) = w; } } }
        return !last;
    }
};
struct EpiOut {
    static constexpr bool PERM = false, AFTER_DRAIN = false, RW = false;
    const float* X; float* C; float alpha;
    __device__ __forceinline__ void operator()(const f32x4 (&acc)[2][2][4][2], const Unit& u, int wr, int wc, int fr, int fq) const {
        const int row0 = u.pm * BM + wr * 64 + fr, col0 = u.pn * BM + wc * 32 + 4 * fq;
#pragma unroll
        for (int ai = 0; ai < 2; ++ai)
#pragma unroll
            for (int m = 0; m < 4; ++m) { const size_t off = (size_t)(row0 + ai * HALF + m * 16) * 4096 + col0;
#pragma unroll
                for (int bj = 0; bj < 2; ++bj)
#pragma unroll
                    for (int n = 0; n < 2; ++n) { const f32x4 xv = *(const f32x4*)(X + off + bj * HALF + n * 16); *(f32x4*)(C + off + bj * HALF + n * 16) = xv * alpha + acc[ai][bj][m][n]; } }
    }
};
struct MergeOrder {
    StaticOrder so;
    __host__ __device__ void init(int G_, int c_) { so.init(16384, 4096, G_, c_); }
    __host__ __device__ bool next(int i, Unit& u) const { Unit t; if (!so.next(i / 3, t)) return false; const int br = i % 3; u.pm = br * 64 + t.pm; u.pn = br * 16 + t.pn; return true; }
    __device__ __forceinline__ void a_ready(const Unit&) const {}
    __device__ __forceinline__ void done(const Unit&) const {}
};
struct H1Order {
    StaticOrder so;
    __host__ __device__ void init(int G_, int c_) { so.init(16384, 29952, G_, c_); }
    __host__ __device__ bool next(int i, Unit& u) const { if (so.next(i, u)) return true; const long e = (long)i * so.G + so.c - so.nwg; if (e < 32) { u.pm = 64 + (int)(e & 1); u.pn = 117 + (int)(e >> 1); return true; } return false; }
    __device__ __forceinline__ void a_ready(const Unit&) const {}
    __device__ __forceinline__ void done(const Unit&) const {}
};
struct EpiH1 {
    static constexpr bool PERM = true, AFTER_DRAIN = false, RW = false;
    bf16_t* O; int ldc; bf16_t* O2; int ldc2;
    __device__ __forceinline__ void operator()(const f32x4 (&acc)[2][2][4][2], const Unit& u, int wr, int wc, int fr, int fq) const {
        const bool ex = u.pm >= 64; bf16_t* base = ex ? O2 : O; const int ld = ex ? ldc2 : ldc;
        const int row0 = (ex ? u.pm - 64 : u.pm) * BM + wr * 64 + fr, col0 = (ex ? u.pn - 117 : u.pn) * BM + wc * 32 + 8 * fq;
#pragma unroll
        for (int ai = 0; ai < 2; ++ai)
#pragma unroll
            for (int m = 0; m < 4; ++m) { bf16_t* rowp = base + (size_t)(row0 + ai * HALF + m * 16) * ld + col0;
#pragma unroll
                for (int bj = 0; bj < 2; ++bj) { const f32x4 v0 = acc[ai][bj][m][0], v1 = acc[ai][bj][m][1];
                    u32x4 w; w.x = cvt_pk_bf16(v0[0], v0[1]); w.y = cvt_pk_bf16(v0[2], v0[3]); w.z = cvt_pk_bf16(v1[0], v1[1]); w.w = cvt_pk_bf16(v1[2], v1[3]);
                    *(u32x4*)(rowp + bj * HALF) = w; } }
    }
};
template <class Epi, class Sched, bool ALIGN_EPI = false, bool SP2 = false>
__device__ __forceinline__ void gemm_phase(PG8_LAS unsigned char* lds, const Gemm g, const Sched& S, const Epi& E) {
    const int tid = threadIdx.x, wid = __builtin_amdgcn_readfirstlane(tid >> 6), lane = tid & 63, wr = wid >> 2, wc = wid & 3, fr = lane & 15, fq = lane >> 4;
    const int K = g.K, nt = K / BK;
    unsigned voffA[2], voffB[2];
#pragma unroll
    for (int i = 0; i < 2; ++i) { int R, C; stage_rc(tid * 16 + i * 8192, R, C); const int Rb = Epi::PERM ? ((R & ~31) + perm32(R & 31)) : R;
        voffA[i] = (unsigned)(R * K + C) * 2u; voffB[i] = (unsigned)(Rb * K + C) * 2u; }
    const size_t kstep = (size_t)(BK * 2);
    const size_t hstep = (size_t)HALF * K * 2;
    const size_t tstep = 2 * hstep;
    const unsigned ldsw = (unsigned)wid * 1024u;
    const int aoff = lds_byte(wr * 64 + fr, fq * 8), boff = lds_byte(wc * 32 + fr, fq * 8);
#define PG8_SA(b, h) (((b) * 2 + (h)) * HTB)
#define PG8_SB(b, h) ((4 + (b) * 2 + (h)) * HTB)
#define PG8_STAGE(bufoff, gbase, voff) do { _Pragma("unroll") for (int _i = 0; _i < 2; ++_i) \
        __builtin_amdgcn_global_load_lds((const unsigned*)((const char*)(gbase) + (voff)[_i]), (PG8_LAS unsigned*)(lds + (bufoff) + ldsw + _i * 8192), 16, 0, 0); } while (0)
#define PG8_LDA(dst, b, h) do { _Pragma("unroll") for (int m = 0; m < 4; ++m) _Pragma("unroll") for (int k = 0; k < 2; ++k) dst[m][k] = *(const PG8_LAS bf16x8*)(lds + PG8_SA(b, h) + aoff + m * 2048 + k * 1024); } while (0)
#define PG8_LDB(dst, b, h) do { _Pragma("unroll") for (int n = 0; n < 2; ++n) _Pragma("unroll") for (int k = 0; k < 2; ++k) dst[n][k] = *(const PG8_LAS bf16x8*)(lds + PG8_SB(b, h) + boff + n * 2048 + k * 1024); } while (0)
#define PG8_MMA(ai, bj, At, Bt) do { __builtin_amdgcn_s_setprio(1); _Pragma("unroll") for (int m = 0; m < 4; ++m) _Pragma("unroll") for (int n = 0; n < 2; ++n) _Pragma("unroll") for (int k = 0; k < 2; ++k) \
        acc[ai][bj][m][n] = __builtin_amdgcn_mfma_f32_16x16x32_bf16(Bt[n][k], At[m][k], acc[ai][bj][m][n], 0, 0, 0); __builtin_amdgcn_s_setprio(0); } while (0)
#define PG8_WAIT_V(n) asm volatile("s_waitcnt vmcnt(" #n ")" ::: "memory")
#define PG8_WAIT_L(n) asm volatile("s_waitcnt lgkmcnt(" #n ")" ::: "memory")
#define PG8_BAR __builtin_amdgcn_s_barrier()
#define PG8_SCHED __builtin_amdgcn_sched_barrier(0)
    Unit cur, nxt; int ui = 0;
    if (!S.next(0, cur)) return;
    f32x4 acc[2][2][4][2];
#pragma unroll
    for (int a = 0; a < 2; ++a)
#pragma unroll
        for (int b = 0; b < 2; ++b)
#pragma unroll
            for (int m = 0; m < 4; ++m)
#pragma unroll
                for (int n = 0; n < 2; ++n) acc[a][b][m][n] = (f32x4){0.f, 0.f, 0.f, 0.f};
    bf16x8 At[4][2], B0[2][2], B1[2][2];
    const char* cA = (const char*)g.A + (size_t)cur.pm * tstep; const char* cB = (const char*)g.Bt + (size_t)cur.pn * tstep;
    S.a_ready(cur);
    if constexpr (SP2) {
        PG8_STAGE(PG8_SB(0, 0), cB, voffB); PG8_STAGE(PG8_SB(0, 1), cB + hstep, voffB); PG8_STAGE(PG8_SA(0, 0), cA, voffA); PG8_STAGE(PG8_SA(0, 1), cA + hstep, voffA);
        if (wr == 1) PG8_BAR;
        PG8_WAIT_V(2); PG8_BAR;
        PG8_STAGE(PG8_SB(1, 0), cB + kstep, voffB); PG8_STAGE(PG8_SA(1, 0), cA + kstep, voffA); PG8_STAGE(PG8_SB(1, 1), cB + hstep + kstep, voffB);
        PG8_WAIT_V(6); PG8_BAR;
    } else {
        PG8_STAGE(PG8_SB(0, 0), cB, voffB); PG8_STAGE(PG8_SA(0, 0), cA, voffA); PG8_STAGE(PG8_SB(0, 1), cB + hstep, voffB); PG8_STAGE(PG8_SA(0, 1), cA + hstep, voffA);
        if (wr == 1) PG8_BAR;
        PG8_WAIT_V(4); PG8_BAR;
        PG8_STAGE(PG8_SB(1, 0), cB + kstep, voffB); PG8_STAGE(PG8_SA(1, 0), cA + kstep, voffA); PG8_STAGE(PG8_SB(1, 1), cB + hstep + kstep, voffB);
        PG8_WAIT_V(6); PG8_BAR;
    }
    for (;;) {
        const bool has_next = S.next(ui + 1, nxt);
        const char* nA = has_next ? (const char*)g.A + (size_t)nxt.pm * tstep : cA; const char* nB = has_next ? (const char*)g.Bt + (size_t)nxt.pn * tstep : cB;
        for (int t = 0; t < nt; t += 2) {
            const bool last = (t == nt - 2);
            const char* a1 = cA + (size_t)(t + 1) * kstep;
            const char* a2 = last ? nA : cA + (size_t)(t + 2) * kstep; const char* b2 = last ? nB : cB + (size_t)(t + 2) * kstep;
            const char* a3 = a2 + kstep; const char* b3 = b2 + kstep;
            if (last && has_next) S.a_ready(nxt);
            if constexpr (SP2) {
            PG8_LDB(B0, 0, 0); PG8_LDB(B1, 0, 1); PG8_SCHED; PG8_LDA(At, 0, 0); PG8_STAGE(PG8_SA(1, 1), a1 + hstep, voffA);
            PG8_WAIT_V(8); PG8_WAIT_L(0); PG8_BAR; PG8_MMA(0, 0, At, B0); PG8_MMA(0, 1, At, B1); PG8_BAR; PG8_SCHED;
            PG8_LDA(At, 0, 1); PG8_STAGE(PG8_SB(0, 0), b2, voffB); PG8_STAGE(PG8_SB(0, 1), b2 + hstep, voffB); PG8_STAGE(PG8_SA(0, 0), a2, voffA);
            PG8_WAIT_V(8); PG8_WAIT_L(0); PG8_BAR; PG8_MMA(1, 0, At, B0); PG8_MMA(1, 1, At, B1); PG8_BAR; PG8_SCHED;
            PG8_LDB(B0, 1, 0); PG8_LDB(B1, 1, 1); PG8_SCHED; PG8_LDA(At, 1, 0); PG8_STAGE(PG8_SA(0, 1), a2 + hstep, voffA);
            PG8_WAIT_V(8); PG8_WAIT_L(0); PG8_BAR; PG8_MMA(0, 0, At, B0); PG8_MMA(0, 1, At, B1); PG8_BAR; PG8_SCHED;
            PG8_LDA(At, 1, 1); PG8_STAGE(PG8_SB(1, 0), b3, voffB); PG8_STAGE(PG8_SB(1, 1), b3 + hstep, voffB); PG8_STAGE(PG8_SA(1, 0), a3, voffA);
            PG8_WAIT_V(8); PG8_WAIT_L(0); PG8_BAR; PG8_MMA(1, 0, At, B0); PG8_MMA(1, 1, At, B1); PG8_BAR; PG8_SCHED;
            } else {
            PG8_LDB(B0, 0, 0); PG8_SCHED; PG8_LDA(At, 0, 0); PG8_STAGE(PG8_SA(1, 1), a1 + hstep, voffA);
            PG8_WAIT_L(8); PG8_BAR; PG8_WAIT_L(0); PG8_MMA(0, 0, At, B0); PG8_BAR; PG8_SCHED;
            PG8_LDB(B1, 0, 1); PG8_STAGE(PG8_SB(0, 0), b2, voffB);
            PG8_BAR; PG8_WAIT_L(0); PG8_MMA(0, 1, At, B1); PG8_BAR;
            PG8_LDA(At, 0, 1); PG8_STAGE(PG8_SA(0, 0), a2, voffA);
            PG8_BAR; PG8_WAIT_L(0); PG8_MMA(1, 0, At, B0); PG8_BAR; PG8_SCHED;
            PG8_STAGE(PG8_SB(0, 1), b2 + hstep, voffB);
            PG8_WAIT_V(6); PG8_BAR; PG8_MMA(1, 1, At, B1); PG8_BAR;
            PG8_LDB(B0, 1, 0); PG8_SCHED; PG8_LDA(At, 1, 0); PG8_STAGE(PG8_SA(0, 1), a2 + hstep, voffA);
            PG8_WAIT_L(8); PG8_BAR; PG8_WAIT_L(0); PG8_MMA(0, 0, At, B0); PG8_BAR; PG8_SCHED;
            PG8_LDB(B1, 1, 1); PG8_STAGE(PG8_SB(1, 0), b3, voffB);
            PG8_BAR; PG8_WAIT_L(0); PG8_MMA(0, 1, At, B1); PG8_BAR;
            PG8_LDA(At, 1, 1); PG8_STAGE(PG8_SA(1, 0), a3, voffA);
            PG8_BAR; PG8_WAIT_L(0); PG8_MMA(1, 0, At, B0); PG8_BAR; PG8_SCHED;
            PG8_STAGE(PG8_SB(1, 1), b3 + hstep, voffB);
            PG8_WAIT_V(6); PG8_BAR; PG8_MMA(1, 1, At, B1); PG8_BAR;
            }
        }
        if constexpr (ALIGN_EPI) { if (wr == 0) PG8_BAR; }
        bool keep_acc = false;
        if constexpr (!Epi::AFTER_DRAIN) { if constexpr (Epi::RW) keep_acc = E.rw(acc, cur, wr, wc, fr, fq); else E(acc, cur, wr, wc, fr, fq); S.done(cur); }
        if (!has_next) break;
        if (!keep_acc) {
#pragma unroll
        for (int a = 0; a < 2; ++a)
#pragma unroll
            for (int b = 0; b < 2; ++b)
#pragma unroll
                for (int m = 0; m < 4; ++m)
#pragma unroll
                    for (int n = 0; n < 2; ++n) acc[a][b][m][n] = (f32x4){0.f, 0.f, 0.f, 0.f};
        }
        cur = nxt; cA = nA; cB = nB; ++ui;
        if constexpr (ALIGN_EPI) { if (wr == 1) PG8_BAR; }
    }
    PG8_WAIT_V(0);
    if constexpr (!ALIGN_EPI) { if (wr == 0) PG8_BAR; }
    PG8_BAR;
    if constexpr (Epi::AFTER_DRAIN) { E.fused(acc, cur, wr, wc, fr, fq, lds, wid, lane); S.done(cur); }
#undef PG8_SA
#undef PG8_SB
#undef PG8_STAGE
#undef PG8_LDA
#undef PG8_LDB
#undef PG8_MMA
#undef PG8_WAIT_V
#undef PG8_WAIT_L
#undef PG8_BAR
#undef PG8_SCHED
}
}
#define XB_TMO      128
#define XB_XCNT(j)  (256  + 64 * (j))
#define XB_XSUB(j)  (1280 + 64 * (j))
#define XB_XGEN(j)  (2304 + 64 * (j))
#define XB_TOP      3328
#define XB_TOPGEN   3392
#define XCD_BAR_WORDS 3456
#define XB_SPIN_CAP (1u << 18)

__device__ __forceinline__ unsigned xb_ld(unsigned* p)              { return __hip_atomic_load(p, __ATOMIC_RELAXED, __HIP_MEMORY_SCOPE_AGENT); }
__device__ __forceinline__ unsigned xb_add(unsigned* p, unsigned v) { return __hip_atomic_fetch_add(p, v, __ATOMIC_RELAXED, __HIP_MEMORY_SCOPE_AGENT); }
__device__ __forceinline__ unsigned xb_xcc_id() { return (unsigned)__builtin_amdgcn_s_getreg((3 << 11) | 20) & 0xFu; }
#define XB_SPIN(cond, bar) do { unsigned _sp = 0; while (cond) { __builtin_amdgcn_s_sleep(1); \
    if ((++_sp & 255u) == 0u) { if (xb_ld(&(bar)[XB_TMO])) break; if (_sp > XB_SPIN_CAP) { atomicAdd(&(bar)[XB_TMO], 1u); break; } } } } while (0)

struct XcdBarrier {
    unsigned* bar; unsigned x;
    volatile LAS unsigned* st;
};

__device__ __forceinline__ XcdBarrier xcd_barrier_post(unsigned* bar, volatile LAS unsigned* st) {
    XcdBarrier b; b.bar = bar; b.x = xb_xcc_id(); b.st = st;
    if (threadIdx.x == 0) (void)xb_add(&bar[XB_XCNT(b.x)], 1u);
    return b;
}
__device__ __forceinline__ void xcd_barrier_complete(unsigned* bar, unsigned x, unsigned& nloc, unsigned& nx) {
    const unsigned G = gridDim.x * gridDim.y * gridDim.z;
    unsigned sum, cnt, mine, sp = 0u;
    for (;;) {
        sum = 0u; cnt = 0u; mine = 0u;
#pragma unroll
        for (unsigned j = 0; j < 16; ++j) { const unsigned c = xb_ld(&bar[XB_XCNT(j)]); sum += c; cnt += (c > 0u) ? 1u : 0u; mine = (j == x) ? c : mine; }
        if (sum == G) break;
        __builtin_amdgcn_s_sleep(1);
        if ((++sp & 255u) == 0u) { if (xb_ld(&bar[XB_TMO])) break; if (sp > XB_SPIN_CAP) { atomicAdd(&bar[XB_TMO], 1u); break; } }
    }
    nloc = mine > 0u ? mine : 1u; nx = cnt > 0u ? cnt : 1u;
}

__device__ __forceinline__ void xcd_barrier(const XcdBarrier& b) {
    asm volatile("s_waitcnt vmcnt(0)" ::: "memory");
    __syncthreads();
    if (threadIdx.x == 0) {
        unsigned* bar = b.bar;
        __builtin_amdgcn_s_waitcnt(0);
        unsigned nloc = b.st[0], nx = b.st[1];
        if (nloc == 0u) { xcd_barrier_complete(bar, b.x, nloc, nx); b.st[0] = nloc; b.st[1] = nx; }
        const unsigned old = xb_add(&bar[XB_XSUB(b.x)], 1u);
        const unsigned gen = old / nloc;
        if (old + 1u == (gen + 1u) * nloc) {
            __builtin_amdgcn_fence(__ATOMIC_RELEASE, "agent");
            asm volatile("s_waitcnt vmcnt(0)" ::: "memory");
            const unsigned og = xb_add(&bar[XB_TOP], 1u);
            const unsigned tg = og / nx;
            if (og + 1u == (tg + 1u) * nx) xb_add(&bar[XB_TOPGEN], 1u);
            else XB_SPIN(xb_ld(&bar[XB_TOPGEN]) == tg, bar);
            __builtin_amdgcn_fence(__ATOMIC_ACQUIRE, "agent");
            xb_add(&bar[XB_XGEN(b.x)], 1u);
            asm volatile("s_waitcnt vmcnt(0)" ::: "memory");
        } else {
            XB_SPIN(xb_ld(&bar[XB_XGEN(b.x)]) == gen, bar);
            __builtin_amdgcn_fence(__ATOMIC_ACQUIRE, "agent");
            asm volatile("s_waitcnt vmcnt(0)" ::: "memory");
        }
    }
    __syncthreads();
}
#define LDS_WAIT() asm volatile("s_waitcnt lgkmcnt(0)" ::: "memory")
struct Frame {
    LAS unsigned char* lds;
    volatile LAS unsigned* MISC;
    gu32* ctl;
    int tid, lane, wave, G, bid;
    unsigned char* ws;
};
struct Args { const float* in[20]; float* out; unsigned char* ws; int ph_lo, ph_hi; };
#define IN_X(A) ((A).in[0])
#define IN_MEM(A) ((A).in[1])
#define IN_WIN(A) ((A).in[2])
#define IN_BMERGE(A) ((A).in[3])
#define IN_WA2(A) ((A).in[4])
#define IN_BA(A) ((A).in[5])
#define IN_NORMG(A) ((A).in[6])
#define IN_PEK(A) ((A).in[7])
#define IN_PEV(A) ((A).in[8])
#define IN_WK1(A) ((A).in[9])
#define IN_WK2(A) ((A).in[10])
#define IN_WV1(A) ((A).in[11])
#define IN_WV2(A) ((A).in[12])
#define IN_WKV(A) ((A).in[13])
#define IN_WOUT(A) ((A).in[17])
#define IN_LNG(A) ((A).in[18])
#define IN_LNB(A) ((A).in[19])
#define WSB(off) ((bf16*)(F.ws + (off)))
#define WSF(off) ((float*)(F.ws + (off)))

DI int wq_next(Frame& F, int cw) {
    __syncthreads();
    if (F.tid == 0) F.MISC[0] = __hip_atomic_fetch_add(F.ctl + cw, 1u, RLX_AGENT);
    __syncthreads();
    return (int)F.MISC[0];
}

template <class Map> DI void transpose_item(const float* W, int K, int Nsrc, bf16* WT, LAS float* scr, int kb, int nb, int lane, Map map) {
    const int k0 = 64 * kb, n0 = 64 * nb;
    const int c4 = lane & 15, kq = lane >> 4;
    const int ns = map(n0 + 4 * c4);
    f32x4 v[16];
#pragma unroll
    for (int it = 0; it < 16; ++it) v[it] = ns >= 0 ? *(const f32x4*)(W + (size_t)(k0 + 4 * it + kq) * Nsrc + ns) : (f32x4){0.f, 0.f, 0.f, 0.f};
#pragma unroll
    for (int it = 0; it < 16; ++it) { LAS float* p = scr + (4 * it + kq) * 65 + 4 * c4; p[0] = v[it][0]; p[1] = v[it][1]; p[2] = v[it][2]; p[3] = v[it][3]; }
    LDS_WAIT(); asm volatile("" ::: "memory");
    const int c = lane & 7;
#pragma unroll
    for (int j = 0; j < 8; ++j) { const int n = (lane >> 3) + 8 * j; const LAS float* s = scr + (8 * c) * 65 + n;
        u32x4 o; o.x = cvtpk(s[0 * 65], s[1 * 65]); o.y = cvtpk(s[2 * 65], s[3 * 65]); o.z = cvtpk(s[4 * 65], s[5 * 65]); o.w = cvtpk(s[6 * 65], s[7 * 65]);
        *(GAS u32x4*)(WT + (size_t)(n0 + n) * K + k0 + 8 * c) = o; }
    LDS_WAIT(); asm volatile("" ::: "memory");
}
struct IdMap { DI int operator()(int n) const { return n; } };
struct WinMap { DI int operator()(int n) const { return win_src_col(n); } };

DI void cvt_rows_bf16(const float* src, bf16* dst, size_t n8, size_t g0, size_t gstride) {
    for (size_t i = g0; i < n8; i += 4 * gstride) { f32x4 a[4], b[4];
#pragma unroll
        for (int u = 0; u < 4; ++u) { const size_t k = i + u * gstride; if (k < n8) { a[u] = ((const f32x4*)src)[2 * k]; b[u] = ((const f32x4*)src)[2 * k + 1]; } }
#pragma unroll
        for (int u = 0; u < 4; ++u) { const size_t k = i + u * gstride; if (k < n8) { u32x4 o; o.x = cvtpk(a[u][0], a[u][1]); o.y = cvtpk(a[u][2], a[u][3]); o.z = cvtpk(b[u][0], b[u][1]); o.w = cvtpk(b[u][2], b[u][3]); ((u32x4*)dst)[k] = o; } } }
}

DI void p0_prologue(Frame& F, const Args& A) {
    LAS float* scr = (LAS float*)(F.lds + F.wave * 16896);
    const int gw = F.bid * NWAVES + F.wave, NGW = F.G * NWAVES;
    constexpr int I_WIN = 64 * (NP / 64), I_KV = 64 * 64, I_BR = 32 * 64, I_OUT = 64 * 64, I_W1 = 64 * 2, I_W2 = 2 * 2;
    constexpr int NITEMS = I_WIN + I_KV + 3 * I_BR + I_OUT + 2 * I_W1 + 2 * I_W2;
    for (int it = gw; it < NITEMS; it += NGW) {
        int r = it;
        if (r < I_WIN) { transpose_item(IN_WIN(A), 4096, D_IN, WSB(WS_WINT), scr, r / (NP / 64), r % (NP / 64), F.lane, WinMap()); continue; } r -= I_WIN;
        if (r < I_KV) { transpose_item(IN_WKV(A), 4096, 4096, WSB(WS_WKVT), scr, r / 64, r % 64, F.lane, IdMap()); continue; } r -= I_KV;
        if (r < 3 * I_BR) { const int br = r / I_BR, q = r % I_BR; transpose_item(br == 0 ? A.in[14] : (br == 1 ? A.in[15] : A.in[16]), 2048, 4096, WSB(WS_WBRT) + (size_t)br * 4096 * 2048, scr, q / 64, q % 64, F.lane, IdMap()); continue; } r -= 3 * I_BR;
        if (r < I_OUT) { transpose_item(IN_WOUT(A), 4096, 4096, WSB(WS_WOUTT), scr, r / 64, r % 64, F.lane, IdMap()); continue; } r -= I_OUT;
        if (r < 2 * I_W1) { const int kv = r / I_W1, q = r % I_W1; transpose_item(kv ? IN_WV1(A) : IN_WK1(A), 4096, 128, WSB(WS_W1T) + (size_t)kv * 128 * 4096, scr, q / 2, q % 2, F.lane, IdMap()); continue; } r -= 2 * I_W1;
        { const int kv = r / I_W2, q = r % I_W2; transpose_item(kv ? IN_WV2(A) : IN_WK2(A), 128, 128, WSB(WS_W2T) + (size_t)kv * 128 * 128, scr, q / 2, q % 2, F.lane, IdMap()); }
    }
    const size_t gt = (size_t)F.bid * 512 + F.tid, GT = (size_t)F.G * 512;
    cvt_rows_bf16(IN_X(A), WSB(WS_XB), (size_t)M * DM / 8, gt, GT);
    cvt_rows_bf16(IN_MEM(A), WSB(WS_MEMB), (size_t)512 * DM / 8, gt, GT);
    for (int o = gw; o < 256; o += NGW) { const int kv = o >> 7, j = o & 127; const float* pe = kv ? IN_PEV(A) : IN_PEK(A); const float* w1 = kv ? IN_WV1(A) : IN_WK1(A);
        float s = 0.f; for (int k = F.lane; k < 4096; k += 64) s += pe[k] * w1[(size_t)k * 128 + j];
        s = wave_sum(s); if (F.lane == 0) WSF(WS_C1)[o] = s; }
}
DI void mem_attn_item(Frame& F, int item) {
    const int tile = item & 63, head = (item >> 6) & 3, b = item >> 8;
    int tid = F.tid; asm volatile("" : "+v"(tid)); const int lane = tid & 63, w = __builtin_amdgcn_readfirstlane(tid >> 6); const int i = lane & 15, g = lane >> 4;
    const int tok = b * SEQ + tile * 128 + 16 * w + i;
    LAS char* KL = (LAS char*)F.lds;
    LAS char* VL = (LAS char*)F.lds + 36864;
    const bf16* qrow = WSB(WS_H) + (size_t)tok * NP + H_MQ + head * 512;
    bf16x8 qf[16];
#pragma unroll
    for (int s = 0; s < 16; ++s) qf[s] = *(const bf16x8*)(qrow + 32 * s + 8 * g);
    f32x4 sacc[16];
#pragma unroll
    for (int kt = 0; kt < 16; ++kt) sacc[kt] = (f32x4){0.f, 0.f, 0.f, 0.f};
    const char* kbase = (const char*)(WSB(WS_KVMEM) + (size_t)(b * 256) * 4096 + head * 512);
#pragma unroll
    for (int dc = 0; dc < 8; ++dc) {
        lds_barrier();
        g2l_tile<256, 8>(KL, 144, kbase + dc * 128, 8192, tid);
        lds_barrier();
#pragma unroll
        for (int s2 = 0; s2 < 2; ++s2)
#pragma unroll
            for (int kt = 0; kt < 16; ++kt) { const bf16x8 a = *(const LAS bf16x8*)(KL + (16 * kt + i) * 144 + (s2 * 32 + 8 * g) * 2); sacc[kt] = mfma16(a, qf[dc * 2 + s2], sacc[kt]); }
    }
    const float scale = 0.04419417382415922f;
    float mx = NEG;
#pragma unroll
    for (int kt = 0; kt < 16; ++kt)
#pragma unroll
        for (int r = 0; r < 4; ++r) mx = fmaxf(mx, sacc[kt][r]);
    mx = fmaxf(mx, __shfl_xor(mx, 16)); mx = fmaxf(mx, __shfl_xor(mx, 32));
    float sum = 0.f;
#pragma unroll
    for (int kt = 0; kt < 16; ++kt)
#pragma unroll
        for (int r = 0; r < 4; ++r) { const float p = __expf((sacc[kt][r] - mx) * scale); sacc[kt][r] = p; sum += p; }
    sum += __shfl_xor(sum, 16); sum += __shfl_xor(sum, 32);
    const float inv = 1.f / sum;
    bf16x8 pf[8];
#pragma unroll
    for (int s = 0; s < 8; ++s) pf[s] = pack2(sacc[2 * s], sacc[2 * s + 1]);
    const char* vbase = (const char*)(WSB(WS_KVMEM) + (size_t)(b * 256) * 4096 + 2048 + head * 512);
    const bf16* zrow = WSB(WS_H) + (size_t)tok * NP + H_MZ + head * 512;
    bf16* orow = WSB(WS_GATED) + (size_t)2 * M * 2048 + (size_t)tok * 2048 + head * 512;
#pragma unroll 1
    for (int dcv = 0; dcv < 4; ++dcv) {
        lds_barrier();
        g2l_tile<256, 16>(VL, 288, vbase + dcv * 256, 8192, tid);
        lds_barrier();
        f32x4 oacc[8];
#pragma unroll
        for (int dt = 0; dt < 8; ++dt) oacc[dt] = (f32x4){0.f, 0.f, 0.f, 0.f};
#pragma unroll
        for (int s = 0; s < 8; ++s)
#pragma unroll
            for (int dt = 0; dt < 8; ++dt) { const bf16x8 a = tr_frag(VL, 288, 16 * dt, 32 * s + 4 * g, 32 * s + 16 + 4 * g, lane); oacc[dt] = mfma16(a, pf[s], oacc[dt]); }
#pragma unroll
        for (int dt = 0; dt < 8; ++dt) { const int d0 = dcv * 128 + 16 * dt + 4 * g;
            const u32x2 z = *(const u32x2*)(zrow + d0);
            const float o0 = oacc[dt][0] * inv * siluf_(bflo(z.x)), o1 = oacc[dt][1] * inv * siluf_(bfhi(z.x)), o2 = oacc[dt][2] * inv * siluf_(bflo(z.y)), o3 = oacc[dt][3] * inv * siluf_(bfhi(z.y));
            u32x2 o; o.x = cvtpk(o0, o1); o.y = cvtpk(o2, o3); *(u32x2*)(orow + d0) = o; }
    }
}

DI void compress_item(Frame& F, int item) {
    const int ntile = item & 3, g = (item >> 2) & 3, b = (item >> 4) & 1, kv = item >> 5;
    int tid = F.tid; asm volatile("" : "+v"(tid)); const int lane = tid & 63, w = __builtin_amdgcn_readfirstlane(tid >> 6); const int i = lane & 15, gq = lane >> 4; (void)tid;
    const int n = ntile * 128 + 16 * w + i, nn = n < 510 ? n : 510;
    const bf16* xbase = WSB(WS_H) + (size_t)(b * SEQ + 16 * nn) * NP + (kv ? H_NVC : H_NKC) + g * 128;
    const bf16* w1t = WSB(WS_W1T) + (size_t)kv * 128 * 4096;
    const bf16* w2t = WSB(WS_W2T) + (size_t)kv * 128 * 128;
    f32x4 acc[8];
#pragma unroll
    for (int jt = 0; jt < 8; ++jt) acc[jt] = *(const f32x4*)(WSF(WS_C1) + kv * 128 + 16 * jt + 4 * gq);
#pragma unroll 2
    for (int s = 0; s < 128; ++s) {
        const bf16x8 bx = *(const bf16x8*)(xbase + (size_t)(s >> 2) * NP + (s & 3) * 32 + 8 * gq);
#pragma unroll
        for (int jt = 0; jt < 8; ++jt) { const bf16x8 aw = *(const bf16x8*)(w1t + (size_t)(16 * jt + i) * 4096 + 32 * s + 8 * gq); acc[jt] = mfma16(aw, bx, acc[jt]); }
    }
#pragma unroll
    for (int jt = 0; jt < 8; ++jt)
#pragma unroll
        for (int r = 0; r < 4; ++r) acc[jt][r] = siluf_(acc[jt][r]);
    bf16x8 hf[4];
#pragma unroll
    for (int s = 0; s < 4; ++s) hf[s] = pack2(acc[2 * s], acc[2 * s + 1]);
    bf16* orow = WSB(WS_CMP) + ((size_t)((kv * 2 + b) * 4 + g) * 512 + n) * 128;
#pragma unroll
    for (int jt = 0; jt < 8; ++jt) {
        f32x4 o = (f32x4){0.f, 0.f, 0.f, 0.f};
#pragma unroll
        for (int s = 0; s < 4; ++s) { const bf16* wr_ = w2t + (size_t)(16 * jt + i) * 128 + 32 * s + 4 * gq;
            const s16x4 lo = *(const s16x4*)wr_, hi = *(const s16x4*)(wr_ + 16);
            const bf16x8 aw = __builtin_shufflevector(lo, hi, 0, 1, 2, 3, 4, 5, 6, 7);
            o = mfma16(aw, hf[s], o); }
        u32x2 ov; if (n <= 510) { ov.x = cvtpk(o[0], o[1]); ov.y = cvtpk(o[2], o[3]); } else { ov.x = 0u; ov.y = 0u; }
        *(u32x2*)(orow + 16 * jt + 4 * gq) = ov;
    }
}
DI void gla_prep_item(Frame& F, const Args& A, int item) {
    const int n = item & 127, h = (item >> 7) & 3, b = item >> 9;
    const int tok0 = b * SEQ + 64 * n;
    int tid = F.tid; asm volatile("" : "+v"(tid)); const int lane = tid & 63, w = __builtin_amdgcn_readfirstlane(tid >> 6); const int i = lane & 15, g = lane >> 4;
    LAS float* LA = (LAS float*)F.lds;
    LAS char* VL = (LAS char*)F.lds;
    LAS char* QL = (LAS char*)F.lds + 67584;
    LAS char* KL = (LAS char*)F.lds + 101376;
    LAS float* GA = (LAS float*)(F.lds + 135168);
    LAS u32x4* ATT = (LAS u32x4*)(F.lds + 139264);
    if (tid < 128) { const int c = tid >> 1, hf = tid & 1; const u32x4 v = *(const u32x4*)(WSB(WS_H) + (size_t)(tok0 + c) * NP + H_SM + 8 * hf);
        LAS float* gp = GA + c * 16 + 8 * hf; gp[0] = bflo(v.x); gp[1] = bfhi(v.x); gp[2] = bflo(v.y); gp[3] = bfhi(v.y); gp[4] = bflo(v.z); gp[5] = bfhi(v.z); gp[6] = bflo(v.w); gp[7] = bfhi(v.w); }
    lds_barrier();
    { const int d = tid & 255, hf = tid >> 8; float wa[16];
#pragma unroll
      for (int j = 0; j < 16; ++j) wa[j] = IN_WA2(A)[j * 1024 + h * 256 + d];
      const float ba = IN_BA(A)[h * 256 + d]; float run = 0.f;
      for (int cc = 0; cc < 32; ++cc) { const int c = hf * 32 + cc; float lg = ba;
#pragma unroll
          for (int j = 0; j < 16; ++j) lg += GA[c * 16 + j] * wa[j];
          const float ls = -(fmaxf(-lg, 0.f) + __logf(1.f + __expf(-fabsf(lg))));
          run += ls * 0.0625f; LA[c * 256 + d] = run; } }
    lds_barrier();
#pragma unroll 1
    for (int it = 0; it < 4; ++it) { const int u = tid + 512 * it, c = u >> 5, d0 = (u & 31) * 8;
        const u32x4 qv = *(const u32x4*)(WSB(WS_H) + (size_t)(tok0 + c) * NP + H_GQ + h * 256 + d0);
        const u32x4 kv = *(const u32x4*)(WSB(WS_H) + (size_t)(tok0 + c) * NP + H_GK + h * 256 + d0);
        const unsigned qw[4] = {qv.x, qv.y, qv.z, qv.w}, kw[4] = {kv.x, kv.y, kv.z, kv.w};
        float qd[8], kd[8], ke[8];
#pragma unroll
        for (int e = 0; e < 8; ++e) { const int d = d0 + e; const float o31 = LA[31 * 256 + d], bl = LA[63 * 256 + d] + o31, bc = LA[c * 256 + d] + (c >= 32 ? o31 : 0.f);
            const float qq = (e & 1) ? bfhi(qw[e >> 1]) : bflo(qw[e >> 1]), kk = (e & 1) ? bfhi(kw[e >> 1]) : bflo(kw[e >> 1]);
            qd[e] = qq * 0.0625f * __expf(bc); kd[e] = kk * __expf(-bc); ke[e] = kk * __expf(bl - bc);
            if (c == 63) WSF(WS_GDEC)[(size_t)item * 256 + d] = __expf(bl); }
        u32x4 o; o.x = cvtpk(qd[0], qd[1]); o.y = cvtpk(qd[2], qd[3]); o.z = cvtpk(qd[4], qd[5]); o.w = cvtpk(qd[6], qd[7]); *(LAS u32x4*)(QL + c * 528 + d0 * 2) = o;
        o.x = cvtpk(kd[0], kd[1]); o.y = cvtpk(kd[2], kd[3]); o.z = cvtpk(kd[4], kd[5]); o.w = cvtpk(kd[6], kd[7]); *(LAS u32x4*)(KL + c * 528 + d0 * 2) = o;
        o.x = cvtpk(ke[0], ke[1]); o.y = cvtpk(ke[2], ke[3]); o.z = cvtpk(ke[4], ke[5]); o.w = cvtpk(ke[6], ke[7]); *(u32x4*)(WSB(WS_KEND) + (size_t)(tok0 + c) * 1024 + h * 256 + d0) = o; }
    lds_barrier();
#pragma unroll 1
    for (int it = 0; it < 4; ++it) { const int u = tid + 512 * it, c = u >> 5, pc = u & 31, g32 = pc >> 2, gg = pc & 3;
        const u32x2 lo = *(const LAS u32x2*)(QL + c * 528 + (32 * g32 + 4 * gg) * 2), hi = *(const LAS u32x2*)(QL + c * 528 + (32 * g32 + 16 + 4 * gg) * 2);
        u32x4 o; o.x = lo.x; o.y = lo.y; o.z = hi.x; o.w = hi.y; *(u32x4*)(WSB(WS_QD) + (size_t)(tok0 + c) * 1024 + h * 256 + 8 * pc) = o; }
    { const int ct = w & 3, jp = w >> 2; f32x4 a0 = (f32x4){0.f, 0.f, 0.f, 0.f}, a1 = a0;
#pragma unroll
      for (int s = 0; s < 8; ++s) { const bf16x8 bq = *(const LAS bf16x8*)(QL + (16 * ct + i) * 528 + (32 * s + 8 * g) * 2);
          const bf16x8 k0 = *(const LAS bf16x8*)(KL + (32 * jp + i) * 528 + (32 * s + 8 * g) * 2), k1 = *(const LAS bf16x8*)(KL + (32 * jp + 16 + i) * 528 + (32 * s + 8 * g) * 2);
          a0 = mfma16(k0, bq, a0); a1 = mfma16(k1, bq, a1); }
      const int c = 16 * ct + i;
#pragma unroll
      for (int r = 0; r < 4; ++r) { if (32 * jp + 4 * g + r > c) a0[r] = 0.f; if (32 * jp + 16 + 4 * g + r > c) a1[r] = 0.f; }
      ATT[(ct * 2 + jp) * 64 + lane] = __builtin_bit_cast(u32x4, pack2(a0, a1)); }
    lds_barrier();
    g2l_tile<64, 64>(VL, 1056, (const char*)(WSB(WS_H) + (size_t)tok0 * NP + H_GV + h * 512), (size_t)NP * 2, tid);
    lds_barrier();
    { f32x4 acc[4][4];
#pragma unroll
      for (int et = 0; et < 4; ++et)
#pragma unroll
          for (int ct = 0; ct < 4; ++ct) acc[et][ct] = (f32x4){0.f, 0.f, 0.f, 0.f};
#pragma unroll
      for (int s = 0; s < 2; ++s) { bf16x8 bfr[4];
#pragma unroll
          for (int ct = 0; ct < 4; ++ct) bfr[ct] = __builtin_bit_cast(bf16x8, ATT[(ct * 2 + s) * 64 + lane]);
#pragma unroll
          for (int et = 0; et < 4; ++et) { const bf16x8 a = tr_frag(VL, 1056, 64 * w + 16 * et, 32 * s + 4 * g, 32 * s + 16 + 4 * g, lane);
#pragma unroll
              for (int ct = 0; ct < 4; ++ct) acc[et][ct] = mfma16(a, bfr[ct], acc[et][ct]); } }
#pragma unroll
      for (int et = 0; et < 4; ++et)
#pragma unroll
          for (int ct = 0; ct < 4; ++ct) *(f32x4*)(WSF(WS_GO) + (size_t)(tok0 + 16 * ct + i) * 2048 + h * 512 + 64 * w + 16 * et + 4 * g) = acc[et][ct]; }
    lds_barrier();
}

DI void gla_scan_item(Frame& F, int item) {
    const int es = item & 3, h = (item >> 2) & 3, b = item >> 4;
    int tid = F.tid; asm volatile("" : "+v"(tid)); const int lane = tid & 63, w = __builtin_amdgcn_readfirstlane(tid >> 6); const int i = lane & 15, g = lane >> 4;
    const int dh = w >> 2, eq = w & 3;
    LAS char* QL = (LAS char*)F.lds;
    LAS char* KL = (LAS char*)F.lds + 33792;
    LAS char* VL = (LAS char*)F.lds + 68608;
    LAS float* GD = (LAS float*)(F.lds + 87040);
    LAS f32x4* RED = (LAS f32x4*)(F.lds + 88064);
    f32x4 S[8][2];
#pragma unroll
    for (int dt = 0; dt < 8; ++dt) { S[dt][0] = (f32x4){0.f, 0.f, 0.f, 0.f}; S[dt][1] = (f32x4){0.f, 0.f, 0.f, 0.f}; }
    u32x4 pq[4], pk[4], pv[2], pg[1];
    const size_t tokb = (size_t)b * SEQ;
    const int ecol = h * 512 + es * 128;
    pf_load<64, 32>(pq, (const char*)(WSB(WS_QD) + tokb * 1024 + h * 256), 2048, tid);
    pf_load<64, 32>(pk, (const char*)(WSB(WS_KEND) + tokb * 1024 + h * 256), 2048, tid);
    pf_load<64, 16>(pv, (const char*)(WSB(WS_H) + tokb * NP + H_GV + ecol), (size_t)NP * 2, tid);
    pf_load<1, 64>(pg, (const char*)(WSF(WS_GDEC) + (size_t)((b * 4 + h) * 128) * 256), 0, tid);
#pragma unroll 1
    for (int n = 0; n < 128; ++n) {
        lds_barrier();
        pf_store<64, 32>(pq, QL, 528, tid); pf_store<64, 32>(pk, KL, 544, tid); pf_store<64, 16>(pv, VL, 288, tid); pf_store<1, 64>(pg, (LAS char*)GD, 0, tid);
        lds_barrier();
        const size_t tok0 = tokb + 64 * n;
        if (n + 1 < 128) { const size_t t1 = tok0 + 64;
            pf_load<64, 32>(pq, (const char*)(WSB(WS_QD) + t1 * 1024 + h * 256), 2048, tid);
            pf_load<64, 32>(pk, (const char*)(WSB(WS_KEND) + t1 * 1024 + h * 256), 2048, tid);
            pf_load<64, 16>(pv, (const char*)(WSB(WS_H) + t1 * NP + H_GV + ecol), (size_t)NP * 2, tid);
            pf_load<1, 64>(pg, (const char*)(WSF(WS_GDEC) + (size_t)((b * 4 + h) * 128 + n + 1) * 256), 0, tid); }
        f32x4 oa[2][4];
#pragma unroll
        for (int et = 0; et < 2; ++et)
#pragma unroll
            for (int ct = 0; ct < 4; ++ct) oa[et][ct] = (f32x4){0.f, 0.f, 0.f, 0.f};
#pragma unroll
        for (int s = 0; s < 4; ++s) { const bf16x8 a0 = pack2(S[2 * s][0], S[2 * s + 1][0]), a1 = pack2(S[2 * s][1], S[2 * s + 1][1]);
#pragma unroll
            for (int ct = 0; ct < 4; ++ct) { const bf16x8 bq = *(const LAS bf16x8*)(QL + (16 * ct + i) * 528 + (128 * dh + 32 * s + 8 * g) * 2); oa[0][ct] = mfma16(a0, bq, oa[0][ct]); oa[1][ct] = mfma16(a1, bq, oa[1][ct]); } }
#pragma unroll
        for (int ct = 0; ct < 4; ++ct) RED[(w * 4 + ct) * 64 + lane] = dh ? oa[0][ct] : oa[1][ct];
#pragma unroll
        for (int dt = 0; dt < 8; ++dt) { const f32x4 gd = *(const LAS f32x4*)(GD + 128 * dh + 16 * dt + 4 * g); S[dt][0] = S[dt][0] * gd; S[dt][1] = S[dt][1] * gd; }
        lds_barrier();
#pragma unroll
        for (int ct = 0; ct < 4; ++ct) { const f32x4 mine = dh ? oa[1][ct] : oa[0][ct]; const f32x4 o = mine + RED[((w ^ 4) * 4 + ct) * 64 + lane];
            *(f32x4*)(WSF(WS_GO2) + (tok0 + 16 * ct + i) * 2048 + ecol + 32 * eq + 16 * dh + 4 * g) = o; }
#pragma unroll
        for (int s = 0; s < 2; ++s) { const bf16x8 bv0 = tr_frag(VL, 288, 32 * eq, 32 * s + 4 * g, 32 * s + 16 + 4 * g, lane), bv1 = tr_frag(VL, 288, 32 * eq + 16, 32 * s + 4 * g, 32 * s + 16 + 4 * g, lane);
#pragma unroll
            for (int dt = 0; dt < 8; ++dt) { const bf16x8 a = tr_frag(KL, 544, 128 * dh + 16 * dt, 32 * s + 4 * g, 32 * s + 16 + 4 * g, lane); S[dt][0] = mfma16(a, bv0, S[dt][0]); S[dt][1] = mfma16(a, bv1, S[dt][1]); } }
    }
    lds_barrier();
}

DI void gla_finalize(Frame& F, const Args& A) {
    const int gw = F.bid * NWAVES + F.wave, NGW = F.G * NWAVES, lane = F.lane;
    const f32x4 g0 = *(const f32x4*)(IN_NORMG(A) + 8 * lane), g1 = *(const f32x4*)(IN_NORMG(A) + 8 * lane + 4);
    for (int idx = gw; idx < M * 4; idx += NGW) { const int tok = idx >> 2, h = idx & 3;
        const float* op = WSF(WS_GO) + (size_t)tok * 2048 + h * 512 + 8 * lane; const float* op2 = WSF(WS_GO2) + (size_t)tok * 2048 + h * 512 + 8 * lane;
        const f32x4 a = *(const f32x4*)op + *(const f32x4*)op2, c = *(const f32x4*)(op + 4) + *(const f32x4*)(op2 + 4);
        float ss = a[0] * a[0] + a[1] * a[1] + a[2] * a[2] + a[3] * a[3] + c[0] * c[0] + c[1] * c[1] + c[2] * c[2] + c[3] * c[3];
        ss = wave_sum(ss);
        const float rs = rsqrtf(ss * (1.f / 512.f) + RMS_EPS);
        const u32x4 z = *(const u32x4*)(WSB(WS_H) + (size_t)tok * NP + H_GZ + h * 512 + 8 * lane);
        u32x4 o;
        o.x = cvtpk(a[0] * rs * g0[0] * siluf_(bflo(z.x)), a[1] * rs * g0[1] * siluf_(bfhi(z.x)));
        o.y = cvtpk(a[2] * rs * g0[2] * siluf_(bflo(z.y)), a[3] * rs * g0[3] * siluf_(bfhi(z.y)));
        o.z = cvtpk(c[0] * rs * g1[0] * siluf_(bflo(z.z)), c[1] * rs * g1[1] * siluf_(bfhi(z.z)));
        o.w = cvtpk(c[2] * rs * g1[2] * siluf_(bflo(z.w)), c[3] * rs * g1[3] * siluf_(bfhi(z.w)));
        *(u32x4*)(WSB(WS_GATED) + (size_t)tok * 2048 + h * 512 + 8 * lane) = o; }
}
DI void qk_tile(f32x4 (&sacc)[4], const LAS char* KL, const bf16x8 (&qf)[4], int i, int grp) {
#pragma unroll
    for (int kt = 0; kt < 4; ++kt) sacc[kt] = (f32x4){0.f, 0.f, 0.f, 0.f};
#pragma unroll
    for (int sh = 0; sh < 2; ++sh) { bf16x8 ak[2][4];
#pragma unroll
        for (int ss = 0; ss < 2; ++ss)
#pragma unroll
            for (int kt = 0; kt < 4; ++kt) ak[ss][kt] = *(const LAS bf16x8*)(KL + (16 * kt + i) * 272 + (32 * (2 * sh + ss) + 8 * grp) * 2);
        __builtin_amdgcn_sched_barrier(0);
#pragma unroll
        for (int ss = 0; ss < 2; ++ss)
#pragma unroll
            for (int kt = 0; kt < 4; ++kt) sacc[kt] = mfma16(ak[ss][kt], qf[2 * sh + ss], sacc[kt]);
    }
}
DI void pv_tile(f32x4 (&oacc)[8], const LAS char* VL, const bf16x8 (&pf)[2], int lane, int grp) {
#pragma unroll
    for (int s2 = 0; s2 < 2; ++s2) { bf16x8 av[8];
#pragma unroll
        for (int dt = 0; dt < 8; ++dt) av[dt] = tr_frag(VL, 288, 16 * dt, 32 * s2 + 4 * grp, 32 * s2 + 16 + 4 * grp, lane);
        __builtin_amdgcn_sched_barrier(0);
#pragma unroll
        for (int dt = 0; dt < 8; ++dt) oacc[dt] = mfma16(av[dt], pf[s2], oacc[dt]);
    }
}
constexpr float NEGS = -1e30f, MINIT = -1e20f;
template <bool MASKED> DI void score_tile(f32x4 (&sacc)[4], float sc2, float slk, float c0, int dl, unsigned lim) {
#pragma unroll
    for (int kt = 0; kt < 4; ++kt)
#pragma unroll
        for (int r = 0; r < 4; ++r) { const int ko = 16 * kt + r; float x = fmaf(sacc[kt][r], sc2, fmaf(slk, (float)ko, c0));
            if (MASKED) x = ((unsigned)(dl - ko) < lim) ? x : NEGS;
            sacc[kt][r] = x; }
}
DI float tile_max(const f32x4 (&sacc)[4]) {
    float tm = fmaxf(fmaxf(sacc[0][0], sacc[0][1]), fmaxf(sacc[0][2], sacc[0][3]));
#pragma unroll
    for (int kt = 1; kt < 4; ++kt) tm = fmaxf(tm, fmaxf(fmaxf(sacc[kt][0], sacc[kt][1]), fmaxf(sacc[kt][2], sacc[kt][3])));
    tm = fmaxf(tm, __shfl_xor(tm, 16)); tm = fmaxf(tm, __shfl_xor(tm, 32));
    return tm;
}
DI void online_tile(f32x4 (&sacc)[4], float& m, float& l, f32x4 (&oacc)[8], const LAS char* VL, int lane, int grp) {
    const float mn = fmaxf(m, tile_max(sacc)), alpha = __builtin_amdgcn_exp2f(m - mn);
    float ps = 0.f;
#pragma unroll
    for (int kt = 0; kt < 4; ++kt)
#pragma unroll
        for (int r = 0; r < 4; ++r) { const float p = __builtin_amdgcn_exp2f(sacc[kt][r] - mn); sacc[kt][r] = p; ps += p; }
    l = l * alpha + ps; m = mn;
#pragma unroll
    for (int dt = 0; dt < 8; ++dt) oacc[dt] = oacc[dt] * alpha;
    bf16x8 pf[2]; pf[0] = pack2(sacc[0], sacc[1]); pf[1] = pack2(sacc[2], sacc[3]);
    pv_tile(oacc, VL, pf, lane, grp);
}

DI void nsa_attend_item(Frame& F, int item) {
    const int qt = 255 - (item & 255), g = (item >> 8) & 3, b = item >> 10;
    int tid = F.tid; asm volatile("" : "+v"(tid)); const int lane = tid & 63, w = __builtin_amdgcn_readfirstlane(tid >> 6); const int i = lane & 15, grp = lane >> 4, ql = i >> 2, r4 = i & 3;
    const int t0 = 32 * qt, qi = 4 * w + ql, t = t0 + qi, head = 4 * g + r4;
    const size_t tok = (size_t)b * SEQ + t;
    const float sl2 = exp2f(-0.5f * (float)(head + 1)) * 1.4426950408889634f;
    const float sc2 = 0.08838834764831845f * 1.4426950408889634f;
    LAS char* const L0 = (LAS char*)F.lds;
#define NSA_KL(c) (L0 + (c) * 35840)
#define NSA_VL(c) (L0 + (c) * 35840 + 17408)
    LAS float* IMPA = (LAS float*)(F.lds + 71680);
    LAS float* IMPB = (LAS float*)(F.lds + 88064);
    LAS unsigned* SELM = (LAS unsigned*)(F.lds + 104448);
    bf16x8 qf[4];
    { const bf16* qrow = WSB(WS_H) + tok * NP + H_NQ + head * 128;
#pragma unroll
      for (int s = 0; s < 4; ++s) qf[s] = *(const bf16x8*)(qrow + 32 * s + 8 * grp); }
    float gate[3];
#pragma unroll
    for (int br = 0; br < 3; ++br) gate[br] = sigmoidf_(bf2f(WSB(WS_H)[tok * NP + H_SM + 16 + head * 3 + br]));
    f32x4 comb[8], oacc[8], sacc[4];
    u32x4 rk[2], rv[2];
#pragma unroll
    for (int dt = 0; dt < 8; ++dt) comb[dt] = (f32x4){0.f, 0.f, 0.f, 0.f};

    const int cnt_t = t >= 31 ? ((t - 31) >> 4) + 1 : 0;
    const int ntile = (2 * qt + 1 + 63) >> 6;
    const char* kcb = (const char*)(WSB(WS_CMP) + (size_t)((0 * 2 + b) * 4 + g) * 512 * 128);
    const char* vcb = (const char*)(WSB(WS_CMP) + (size_t)((1 * 2 + b) * 4 + g) * 512 * 128);
    pf_load<64, 16>(rk, kcb, 256, tid);
    for (int u = tid; u < 8192; u += 512) IMPA[u] = 0.f;
    pf_store<64, 16>(rk, NSA_KL(0), 272, tid);
    lds_barrier();
    const int cnt_min = t0 >= 31 ? ((t0 - 31) >> 4) + 1 : 0;
    float m = MINIT, l = 0.f;
#pragma unroll 1
    for (int T = 0; T < ntile; ++T) { const int cb = T & 1; const bool hn = T + 1 < ntile;
        if (hn) pf_load<64, 16>(rk, kcb + (size_t)(T + 1) * 64 * 256, 256, tid);
        qk_tile(sacc, NSA_KL(cb), qf, i, grp);
        { const int nb = 64 * T + 4 * grp; const float c0 = -sl2 * (float)(t - 31 - 16 * nb);
          if (64 * T + 63 < cnt_min) score_tile<false>(sacc, sc2, 16.f * sl2, c0, 0, 0u); else score_tile<true>(sacc, sc2, 16.f * sl2, c0, cnt_t - 1 - nb, 0x80000000u); }
        const float mn = fmaxf(m, tile_max(sacc)); float ps = 0.f;
#pragma unroll
        for (int kt = 0; kt < 4; ++kt)
#pragma unroll
            for (int r = 0; r < 4; ++r) ps += __builtin_amdgcn_exp2f(sacc[kt][r] - mn);
        l = l * __builtin_amdgcn_exp2f(m - mn) + ps; m = mn;
        if (hn) pf_store<64, 16>(rk, NSA_KL(cb ^ 1), 272, tid);
        lds_barrier();
    }
    l += __shfl_xor(l, 16); l += __shfl_xor(l, 32);
    const float inv = (cnt_t > 0 && l > 0.f) ? 1.f / l : 0.f;
#pragma unroll
    for (int dt = 0; dt < 8; ++dt) oacc[dt] = (f32x4){0.f, 0.f, 0.f, 0.f};
    pf_load<64, 16>(rk, kcb, 256, tid); pf_load<64, 16>(rv, vcb, 256, tid);
    pf_store<64, 16>(rk, NSA_KL(0), 272, tid); pf_store<64, 16>(rv, NSA_VL(0), 288, tid);
    lds_barrier();
#pragma unroll 1
    for (int T = 0; T < ntile; ++T) { const int cb = T & 1; const bool hn = T + 1 < ntile;
        if (hn) { pf_load<64, 16>(rk, kcb + (size_t)(T + 1) * 64 * 256, 256, tid); pf_load<64, 16>(rv, vcb + (size_t)(T + 1) * 64 * 256, 256, tid); }
        qk_tile(sacc, NSA_KL(cb), qf, i, grp);
        { const int nb = 64 * T + 4 * grp; const float c0 = -sl2 * (float)(t - 31 - 16 * nb);
          if (64 * T + 63 < cnt_min) score_tile<false>(sacc, sc2, 16.f * sl2, c0, 0, 0u); else score_tile<true>(sacc, sc2, 16.f * sl2, c0, cnt_t - 1 - nb, 0x80000000u); }
#pragma unroll
        for (int kt = 0; kt < 4; ++kt) {
#pragma unroll
            for (int r = 0; r < 4; ++r) sacc[kt][r] = __builtin_amdgcn_exp2f(sacc[kt][r] - m) * inv;
            f32x4 ps = sacc[kt];
#pragma unroll
            for (int r = 0; r < 4; ++r) { ps[r] += __shfl_xor(ps[r], 1); ps[r] += __shfl_xor(ps[r], 2); }
            const int j = 16 * T + 4 * kt + grp;
            if (r4 == 0) { IMPA[qi * 128 + j] = (ps[0] + ps[1]) + (ps[2] + ps[3]); if (j + 1 < 128) IMPB[qi * 128 + j + 1] = ps[3]; }
        }
        bf16x8 pf[2]; pf[0] = pack2(sacc[0], sacc[1]); pf[1] = pack2(sacc[2], sacc[3]);
        pv_tile(oacc, NSA_VL(cb), pf, lane, grp);
        if (hn) { pf_store<64, 16>(rk, NSA_KL(cb ^ 1), 272, tid); pf_store<64, 16>(rv, NSA_VL(cb ^ 1), 288, tid); }
        lds_barrier();
    }
#pragma unroll
    for (int dt = 0; dt < 8; ++dt) comb[dt] = comb[dt] + oacc[dt] * gate[0];

    const int cur = t0 >> 6;
    const char* const hb = (const char*)(WSB(WS_H) + (size_t)b * SEQ * NP + g * 128);
    const int jlo = t0 >= 511 ? (t0 - 511) >> 6 : 0;
    { const int j0 = lane, j1 = lane + 64; float v0[4], v1[4]; bool s0[4], s1[4];
#pragma unroll
      for (int qq = 0; qq < 4; ++qq) { const int q = 4 * w + qq;
          v0[qq] = (j0 == 0 || j0 == cur || j0 == cur - 1) ? 1e4f : (j0 <= cur ? IMPA[q * 128 + j0] + IMPB[q * 128 + j0] : -1.f);
          v1[qq] = (j1 == cur || j1 == cur - 1) ? 1e4f : (j1 <= cur ? IMPA[q * 128 + j1] + IMPB[q * 128 + j1] : -1.f);
          s0[qq] = false; s1[qq] = false; }
#pragma unroll 1
      for (int round = 0; round < 16; ++round) { float bv[4]; int bi[4];
#pragma unroll
          for (int qq = 0; qq < 4; ++qq) { bv[qq] = v0[qq]; bi[qq] = j0; if (v1[qq] > v0[qq]) { bv[qq] = v1[qq]; bi[qq] = j1; } }
#pragma unroll
          for (int off = 32; off >= 1; off >>= 1) {
#pragma unroll
              for (int qq = 0; qq < 4; ++qq) { const float ov = __shfl_xor(bv[qq], off); const int oi = __shfl_xor(bi[qq], off); if (ov > bv[qq] || (ov == bv[qq] && oi < bi[qq])) { bv[qq] = ov; bi[qq] = oi; } } }
#pragma unroll
          for (int qq = 0; qq < 4; ++qq) { if (bi[qq] == j0) { v0[qq] = -2.f; s0[qq] = true; } if (bi[qq] == j1) { v1[qq] = -2.f; s1[qq] = true; } } }
#pragma unroll
      for (int qq = 0; qq < 4; ++qq) { const int q = 4 * w + qq; const unsigned long long b0 = __ballot(s0[qq]), b1 = __ballot(s1[qq]);
          if (lane == 0) { SELM[q * 4 + 0] = (unsigned)b0; SELM[q * 4 + 1] = (unsigned)(b0 >> 32); SELM[q * 4 + 2] = (unsigned)b1; SELM[q * 4 + 3] = (unsigned)(b1 >> 32); } } }
    lds_barrier();
    unsigned u0 = 0u, u1 = 0u, u2 = 0u, u3 = 0u;
    for (int q = 0; q < 32; ++q) { u0 |= SELM[q * 4 + 0]; u1 |= SELM[q * 4 + 1]; u2 |= SELM[q * 4 + 2]; u3 |= SELM[q * 4 + 3]; }
    const unsigned mm0 = SELM[qi * 4 + 0], mm1 = SELM[qi * 4 + 1], mm2 = SELM[qi * 4 + 2], mm3 = SELM[qi * 4 + 3];
    u0 = __builtin_amdgcn_readfirstlane(u0 & (cur >= 31 ? 0xffffffffu : ((2u << cur) - 1u)));
    u1 = __builtin_amdgcn_readfirstlane(u1 & (cur >= 63 ? 0xffffffffu : (cur < 32 ? 0u : ((2u << (cur - 32)) - 1u))));
    u2 = __builtin_amdgcn_readfirstlane(u2 & (cur >= 95 ? 0xffffffffu : (cur < 64 ? 0u : ((2u << (cur - 64)) - 1u))));
    u3 = __builtin_amdgcn_readfirstlane(u3 & (cur >= 127 ? 0xffffffffu : (cur < 96 ? 0u : ((2u << (cur - 96)) - 1u))));

    m = MINIT; l = 0.f;
#pragma unroll
    for (int dt = 0; dt < 8; ++dt) oacc[dt] = (f32x4){0.f, 0.f, 0.f, 0.f};
    LAS int* LIST = (LAS int*)(F.lds + 104960);
    if (tid < 128) { const int p = tid; const unsigned wv = p < 32 ? u0 : (p < 64 ? u1 : (p < 96 ? u2 : u3));
        if ((wv >> (p & 31)) & 1u) { int idx = __popc(wv & ((1u << (p & 31)) - 1u)); if (p >= 32) idx += __popc(u0); if (p >= 64) idx += __popc(u1); if (p >= 96) idx += __popc(u2); LIST[idx] = p; } }
    const int nblk = __popc(u0) + __popc(u1) + __popc(u2) + __popc(u3);
    lds_barrier();
    { int j = __builtin_amdgcn_readfirstlane(LIST[0]);
      { const char* kb = hb + (size_t)(64 * j) * NP * 2 + H_NKS * 2;
          pf_load<64, 16>(rk, kb, (size_t)NP * 2, tid); pf_load<64, 16>(rv, kb + (H_NVS - H_NKS) * 2, (size_t)NP * 2, tid);
          pf_store<64, 16>(rk, NSA_KL(0), 272, tid); pf_store<64, 16>(rv, NSA_VL(0), 288, tid); }
      lds_barrier();
#pragma unroll 1
      for (int it = 0; it < nblk; ++it) { const int cb = it & 1; const bool hn = it + 1 < nblk; const int jn = hn ? __builtin_amdgcn_readfirstlane(LIST[it + 1]) : 0;
          if (hn) { const char* kb = hb + (size_t)(64 * jn) * NP * 2 + H_NKS * 2;
              pf_load<64, 16>(rk, kb, (size_t)NP * 2, tid); pf_load<64, 16>(rv, kb + (H_NVS - H_NKS) * 2, (size_t)NP * 2, tid); }
          qk_tile(sacc, NSA_KL(cb), qf, i, grp);
          const unsigned mw = j < 32 ? mm0 : (j < 64 ? mm1 : (j < 96 ? mm2 : mm3));
          const bool sel = (mw >> (j & 31)) & 1u;
          { const int dl = t - 64 * j - 4 * grp; const float c0 = sel ? -sl2 * (float)dl : NEGS;
            if (j < cur) score_tile<false>(sacc, sc2, sl2, c0, 0, 0u); else score_tile<true>(sacc, sc2, sl2, c0, dl, 0x80000000u); }
          online_tile(sacc, m, l, oacc, NSA_VL(cb), lane, grp);
          if (hn) { pf_store<64, 16>(rk, NSA_KL(cb ^ 1), 272, tid); pf_store<64, 16>(rv, NSA_VL(cb ^ 1), 288, tid); }
          lds_barrier();
          j = jn; } }
    l += __shfl_xor(l, 16); l += __shfl_xor(l, 32);
    { const float il = l > 0.f ? gate[1] / l : 0.f;
#pragma unroll
      for (int dt = 0; dt < 8; ++dt) comb[dt] = comb[dt] + oacc[dt] * il; }

    m = MINIT; l = 0.f;
#pragma unroll
    for (int dt = 0; dt < 8; ++dt) oacc[dt] = (f32x4){0.f, 0.f, 0.f, 0.f};
    { const char* kb = hb + (size_t)(64 * jlo) * NP * 2 + H_NKW * 2;
      pf_load<64, 16>(rk, kb, (size_t)NP * 2, tid); pf_load<64, 16>(rv, kb + (H_NVW - H_NKW) * 2, (size_t)NP * 2, tid);
      pf_store<64, 16>(rk, NSA_KL(0), 272, tid); pf_store<64, 16>(rv, NSA_VL(0), 288, tid); }
    lds_barrier();
#pragma unroll 1
    for (int j = jlo; j <= cur; ++j) { const int cb = (j - jlo) & 1; const bool hn = j + 1 <= cur;
        if (hn) { const char* kb = hb + (size_t)(64 * (j + 1)) * NP * 2 + H_NKW * 2;
            pf_load<64, 16>(rk, kb, (size_t)NP * 2, tid); pf_load<64, 16>(rv, kb + (H_NVW - H_NKW) * 2, (size_t)NP * 2, tid); }
        qk_tile(sacc, NSA_KL(cb), qf, i, grp);
        { const int dl = t - 64 * j - 4 * grp; const float c0 = -sl2 * (float)dl;
          if (64 * j + 63 <= t0 && 64 * j >= t0 - 480) score_tile<false>(sacc, sc2, sl2, c0, 0, 0u); else score_tile<true>(sacc, sc2, sl2, c0, dl, 512u); }
        online_tile(sacc, m, l, oacc, NSA_VL(cb), lane, grp);
        if (hn) { pf_store<64, 16>(rk, NSA_KL(cb ^ 1), 272, tid); pf_store<64, 16>(rv, NSA_VL(cb ^ 1), 288, tid); }
        lds_barrier();
    }
    l += __shfl_xor(l, 16); l += __shfl_xor(l, 32);
    { const float il = l > 0.f ? gate[2] / l : 0.f;
#pragma unroll
      for (int dt = 0; dt < 8; ++dt) comb[dt] = comb[dt] + oacc[dt] * il; }

    { const bf16* zrow = WSB(WS_H) + tok * NP + H_NZ + head * 128; bf16* orow = WSB(WS_GATED) + (size_t)1 * M * 2048 + tok * 2048 + head * 128;
#pragma unroll
      for (int dt = 0; dt < 8; ++dt) { const int d0 = 16 * dt + 4 * grp; const u32x2 z = *(const u32x2*)(zrow + d0);
          u32x2 o; o.x = cvtpk(comb[dt][0] * siluf_(bflo(z.x)), comb[dt][1] * siluf_(bfhi(z.x))); o.y = cvtpk(comb[dt][2] * siluf_(bflo(z.y)), comb[dt][3] * siluf_(bfhi(z.y)));
          *(u32x2*)(orow + d0) = o; } }
#undef NSA_KL
#undef NSA_VL
}
DI void ln_rows(Frame& F, const Args& A) {
    const int gw = F.bid * NWAVES + F.wave, NGW = F.G * NWAVES, lane = F.lane;
    for (int row = gw; row < M; row += NGW) {
        f32x4* rp = (f32x4*)(A.out + (size_t)row * DM) + lane;
        f32x4 v[16]; float s = 0.f;
#pragma unroll
        for (int j = 0; j < 16; ++j) { v[j] = rp[64 * j]; s += (v[j][0] + v[j][1]) + (v[j][2] + v[j][3]); }
        const float mean = wave_sum(s) * (1.f / DM); float q = 0.f;
#pragma unroll
        for (int j = 0; j < 16; ++j) { v[j] = v[j] - mean; q += (v[j][0] * v[j][0] + v[j][1] * v[j][1]) + (v[j][2] * v[j][2] + v[j][3] * v[j][3]); }
        const float rstd = rsqrtf(wave_sum(q) * (1.f / DM) + LN_EPS);
#pragma unroll
        for (int j = 0; j < 16; ++j) { const f32x4 gg = ((const f32x4*)IN_LNG(A))[lane + 64 * j], bb = ((const f32x4*)IN_LNB(A))[lane + 64 * j]; rp[64 * j] = v[j] * rstd * gg + bb; }
    }
}

constexpr int N_PHASES = 8;
__global__ void __launch_bounds__(NWAVES * 64, 2) mk_fwd(Args args) {
    extern __shared__ __attribute__((aligned(16))) unsigned char lds_raw[];
    Frame F;
    F.lds = (LAS unsigned char*)lds_raw;
    F.MISC = (volatile LAS unsigned*)(F.lds + MISC_OFF);
    F.tid = threadIdx.x; F.lane = F.tid & 63; F.wave = __builtin_amdgcn_readfirstlane(F.tid >> 6);
    F.G = gridDim.x; F.bid = blockIdx.x;
    F.ws = args.ws;
    F.ctl = (gu32*)(F.ws + WS_CTL);
    for (int u = F.tid; u < 64; u += NWAVES * 64) ((LAS unsigned*)(F.lds + MISC_OFF))[u] = 0u;
    __syncthreads();
    const int lo = args.ph_lo, hi = args.ph_hi;
    XcdBarrier bar; bar.bar = (unsigned*)(F.ctl + CW_BAR); bar.x = 0; bar.st = nullptr;
    if (hi - lo > 1) bar = xcd_barrier_post((unsigned*)(F.ctl + CW_BAR), F.MISC + 8);
#ifndef MK_PHASE_MASK
#define MK_PHASE_MASK 0xFF
#endif
#define IN(k) (((MK_PHASE_MASK >> (k)) & 1) && lo <= (k) && (k) < hi)
#define SEAM(k) do { if (IN(k) && IN((k) + 1)) xcd_barrier(bar); } while (0)

    if (IN(0)) { p0_prologue(F, args); }
    SEAM(0);
    if (IN(1)) {
        pg8::Gemm gm{WSB(WS_XB), WSB(WS_WINT), M + 512, NP + 4096, 4096}; pg8::H1Order S; S.init(F.G, F.bid); pg8::EpiH1 E{WSB(WS_H), NP, WSB(WS_KVMEM), 4096};
        pg8::gemm_phase<pg8::EpiH1, pg8::H1Order, true, true>(F.lds, gm, S, E);
    }
    SEAM(1);
    if (IN(2)) {
        for (;;) { const int it = wq_next(F, CW_Q2); if (it >= 64 + 512 + 1024) break;

#ifndef MK_NO_CMP
            if (it < 64) compress_item(F, it);
#endif
#ifndef MK_NO_MEM
            if (it >= 64 && it < 576) mem_attn_item(F, it - 64);
#endif
#ifndef MK_NO_PREP
            if (it >= 576) gla_prep_item(F, args, it - 576);
#endif
        }
    }
    SEAM(2);
    if (IN(3)) {
        const int x0 = (int)(xb_xcc_id() & 7u);
#pragma unroll 1
        for (int kq = 0; kq < 8; ++kq) { const int xq = (x0 + kq) & 7;
            for (;;) { const int li = wq_next(F, CW_Q3 + 64 * xq);
#ifdef MK_PROBE_ATT
                if (li >= 4 + 512) break;
#else
                if (li >= 4 + 256) break;
#endif
#ifndef MK_NO_SCAN
                if (li < 4) gla_scan_item(F, xq * 4 + li);
#endif
#ifndef MK_NO_ATT
                if (li >= 4) nsa_attend_item(F, xq * 256 + ((li - 4) & 255));
#endif
            } }
    }
    SEAM(3);
    if (IN(4)) { gla_finalize(F, args); }
    SEAM(4);
    if (IN(5)) {
        pg8::Gemm gm{WSB(WS_GATED), WSB(WS_WBRT), 3 * M, 3 * 4096, 2048}; pg8::MergeOrder S; S.init(F.G, F.bid); pg8::EpiMerge E{WSB(WS_H), NP, H_MRG, IN_BMERGE(args), WSB(WS_MERGED)};
        pg8::gemm_phase<pg8::EpiMerge, pg8::MergeOrder, true, true>(F.lds, gm, S, E);
    }
    SEAM(5);
    if (IN(6)) {
        pg8::Gemm gm{WSB(WS_MERGED), WSB(WS_WOUTT), M, 4096, 4096}; pg8::StaticOrder S; S.init(M, 4096, F.G, F.bid); pg8::EpiOut E{IN_X(args), args.out, ALPHA};
        pg8::gemm_phase<pg8::EpiOut, pg8::StaticOrder, true, true>(F.lds, gm, S, E);
    }
    SEAM(6);
    if (IN(7)) { ln_rows(F, args); }
#undef IN
#undef SEAM
}

extern "C" void kernel_launch(void* const* d_in, const int* in_sizes, int n_in, void* d_out, int out_size, void* d_ws, size_t ws_size, hipStream_t stream) {
    static int grid = 0;
    if (grid == 0) {
        if (n_in != 20 || in_sizes[0] != M * DM || out_size != M * DM || ws_size < WS_END) { fprintf(stderr, "kernel_launch: unexpected problem (n_in %d in0 %d out %d ws %zu); nothing launched\n", n_in, n_in > 0 ? in_sizes[0] : -1, out_size, ws_size); grid = -1; return; }
        int dev = 0, cus = 0, per_cu = 0;
        if (hipGetDevice(&dev) != hipSuccess || hipDeviceGetAttribute(&cus, hipDeviceAttributeMultiprocessorCount, dev) != hipSuccess) { grid = -1; return; }
        if (hipFuncSetAttribute((const void*)mk_fwd, hipFuncAttributeMaxDynamicSharedMemorySize, LDS_BYTES) != hipSuccess) { fprintf(stderr, "kernel_launch: hipFuncSetAttribute failed\n"); grid = -1; return; }
        if (hipOccupancyMaxActiveBlocksPerMultiprocessor(&per_cu, (const void*)mk_fwd, NWAVES * 64, LDS_BYTES) != hipSuccess || per_cu < 1) { fprintf(stderr, "kernel_launch: occupancy query reports %d blocks per CU\n", per_cu); (void)hipGetLastError(); grid = -1; return; }
        grid = cus;
    }
    if (grid < 0) return;
    if (hipMemsetAsync((char*)d_ws + WS_CTL, 0, CTL_ZERO_BYTES, stream) != hipSuccess) return;
    Args a{};
    for (int i = 0; i < 20; ++i) a.in[i] = (const float*)d_in[i];
    a.out = (float*)d_out; a.ws = (unsigned char*)d_ws;
#if MK_SINGLE
    a.ph_lo = 0; a.ph_hi = N_PHASES;
    hipLaunchKernelGGL(mk_fwd, dim3(grid), dim3(NWAVES * 64), LDS_BYTES, stream, a);
#else
    for (int p = 0; p < N_PHASES; ++p) { a.ph_lo = p; a.ph_hi = p + 1; hipLaunchKernelGGL(mk_fwd, dim3(grid), dim3(NWAVES * 64), LDS_BYTES, stream, a);
#ifdef MK_PROBE
        if (p == MK_PROBE) { (void)hipMemsetAsync((char*)d_ws + WS_CTL, 0, CTL_ZERO_BYTES, stream);
            if (MK_PROBE == 3) { a.ph_lo = 2; a.ph_hi = 3; hipLaunchKernelGGL(mk_fwd, dim3(grid), dim3(NWAVES * 64), LDS_BYTES, stream, a); a.ph_lo = 3; a.ph_hi = 4; }
            hipLaunchKernelGGL(mk_fwd, dim3(grid), dim3(NWAVES * 64), LDS_BYTES, stream, a); }
#endif
    }
#endif
}
```

```cpp
#include <hip/hip_runtime.h>
#include <cstdio>
#include <cstdint>

#ifndef MK_SINGLE
#define MK_SINGLE 1
#endif

#define DI __device__ __forceinline__
#define LAS __attribute__((address_space(3)))
#define GAS __attribute__((address_space(1)))
typedef unsigned short bf16;
typedef short bf16x8 __attribute__((ext_vector_type(8)));
typedef short s16x4 __attribute__((ext_vector_type(4)));
typedef short v4i16_t __attribute__((ext_vector_type(4)));
typedef float f32x4 __attribute__((ext_vector_type(4)));
typedef float f32x2_t __attribute__((ext_vector_type(2)));
typedef __bf16 bf16x2_t __attribute__((ext_vector_type(2)));
typedef unsigned u32x4 __attribute__((ext_vector_type(4)));
typedef unsigned u32x2 __attribute__((ext_vector_type(2)));
typedef GAS unsigned gu32;
#define RLX_AGENT __ATOMIC_RELAXED, __HIP_MEMORY_SCOPE_AGENT

constexpr int DM = 4096, BATCH = 2, SEQ = 8192, M = BATCH * SEQ;
constexpr int D_IN = 29760;
constexpr int NP = 29952;
constexpr int H_GQ = 0, H_GK = 1024, H_GV = 2048, H_GZ = 4096, H_NQ = 6144, H_NKC = 8192, H_NVC = 8704, H_NKS = 9216, H_NVS = 9728,
              H_NKW = 10240, H_NVW = 10752, H_NZ = 11264, H_MQ = 13312, H_MZ = 15360, H_MRG = 17408, H_SM = 29696;
constexpr float ALPHA = 1.189207115002721f;
constexpr float LN_EPS = 1e-5f, RMS_EPS = 1e-6f;
constexpr float NEG = -1e30f;

__host__ __device__ __forceinline__ int win_src_col(int n) {
    if (n < 6144) return n;
    if (n < 13312) return n + 16;
    if (n < 29696) return n + 64;
    if (n < 29712) return n - 29696 + 6144;
    if (n < 29760) return n - 29712 + 13328;
    return -1;
}

constexpr size_t MiB = 1u << 20;
constexpr size_t WS_CTL = 0, CTL_ZERO_BYTES = 64 * 1024;
constexpr size_t WS_C1 = 512 * 1024;
constexpr size_t WS_WINT = 2 * MiB;
constexpr size_t WS_WKVT = 236 * MiB;
constexpr size_t WS_XB = 268 * MiB;
constexpr size_t WS_MEMB = 396 * MiB;
constexpr size_t WS_H = 400 * MiB;
constexpr size_t WS_KVMEM = 1336 * MiB;
constexpr size_t WS_WBRT = 1340 * MiB;
constexpr size_t WS_WOUTT = 1388 * MiB;
constexpr size_t WS_W1T = 1420 * MiB;
constexpr size_t WS_W2T = 1422 * MiB;
constexpr size_t WS_CMP = 1423 * MiB;
constexpr size_t WS_GDEC = 1425 * MiB;
constexpr size_t WS_QD = 1426 * MiB;
constexpr size_t WS_KEND = 1458 * MiB;
constexpr size_t WS_MERGED = 1490 * MiB;
constexpr size_t WS_GO2 = 1618 * MiB;
constexpr size_t WS_END = 1746 * MiB;
constexpr size_t WS_GATED = 2 * MiB;
constexpr size_t WS_GO = 268 * MiB;
static_assert(WS_GATED + 3 * (size_t)M * 2048 * 2 <= WS_WKVT && WS_GO + (size_t)M * 2048 * 4 <= WS_MEMB, "overlays");
static_assert(WS_WINT + (size_t)NP * 4096 * 2 == WS_WKVT && WS_XB + (size_t)M * 4096 * 2 == WS_MEMB, "P1 treats [xb ; memb] and [w_in_t ; w_kv_t] as single matrices");
constexpr int CW_Q2 = 64, CW_Q3 = 128;
constexpr int CW_BAR = 4096;

constexpr int LDS_BYTES = 155648;
constexpr int MISC_OFF = LDS_BYTES - 256;
constexpr int NWAVES = 8;

DI float bflo(unsigned w) { return __uint_as_float(w << 16); }
DI float bfhi(unsigned w) { return __uint_as_float(w & 0xffff0000u); }
DI float bf2f(bf16 b) { return __uint_as_float(((unsigned)b) << 16); }
DI unsigned cvtpk(float lo, float hi) { f32x2_t v = {lo, hi}; bf16x2_t b = __builtin_convertvector(v, bf16x2_t); return __builtin_bit_cast(unsigned, b); }
DI f32x4 mfma16(bf16x8 a, bf16x8 b, f32x4 c) { return __builtin_amdgcn_mfma_f32_16x16x32_bf16(a, b, c, 0, 0, 0); }
DI bf16x8 pack2(f32x4 a, f32x4 b) { u32x4 p; p.x = cvtpk(a[0], a[1]); p.y = cvtpk(a[2], a[3]); p.z = cvtpk(b[0], b[1]); p.w = cvtpk(b[2], b[3]); return __builtin_bit_cast(bf16x8, p); }
DI s16x4 trread(const LAS char* p) { return __builtin_bit_cast(s16x4, __builtin_amdgcn_ds_read_tr16_b64_v4i16((LAS v4i16_t*)p)); }
DI bf16x8 tr_frag(const LAS char* img, int RS, int m0, int kA, int kB, int lane) {
    const int q = (lane & 15) >> 2, p = lane & 3;
    const s16x4 lo = trread(img + (kA + q) * RS + (m0 + 4 * p) * 2);
    const s16x4 hi = trread(img + (kB + q) * RS + (m0 + 4 * p) * 2);
    return __builtin_shufflevector(lo, hi, 0, 1, 2, 3, 4, 5, 6, 7);
}
DI float wave_sum(float v) {
#pragma unroll
    for (int o = 1; o < 64; o <<= 1) v += __shfl_xor(v, o);
    return v;
}
DI void lds_barrier() { asm volatile("s_waitcnt lgkmcnt(0)" ::: "memory"); __builtin_amdgcn_s_barrier(); asm volatile("" ::: "memory"); }
DI float sigmoidf_(float x) { return 1.f / (1.f + __expf(-x)); }
DI float siluf_(float x) { return x / (1.f + __expf(-x)); }
template <int ROWS, int CHUNKS> DI void g2l_tile(LAS char* dst, int dstRS, const char* src, size_t srcRS, int tid) {
#pragma unroll
    for (int it = 0; it < (ROWS * CHUNKS + 511) / 512; ++it) { const int idx = tid + it * 512;
        if ((ROWS * CHUNKS) % 512 == 0 || idx < ROWS * CHUNKS) { const int r = idx / CHUNKS, c = idx % CHUNKS;
            *(LAS u32x4*)(dst + r * dstRS + c * 16) = *(const u32x4*)(src + (size_t)r * srcRS + c * 16); } }
}
template <int ROWS, int CHUNKS> DI void pf_load(u32x4 (&v)[(ROWS * CHUNKS + 511) / 512], const char* src, size_t srcRS, int tid) {
#pragma unroll
    for (int it = 0; it < (ROWS * CHUNKS + 511) / 512; ++it) { const int idx = tid + it * 512;
        if ((ROWS * CHUNKS) % 512 == 0 || idx < ROWS * CHUNKS) { const int r = idx / CHUNKS, c = idx % CHUNKS; v[it] = *(const u32x4*)(src + (size_t)r * srcRS + c * 16); } }
}
template <int ROWS, int CHUNKS> DI void pf_store(const u32x4 (&v)[(ROWS * CHUNKS + 511) / 512], LAS char* dst, int dstRS, int tid) {
#pragma unroll
    for (int it = 0; it < (ROWS * CHUNKS + 511) / 512; ++it) { const int idx = tid + it * 512;
        if ((ROWS * CHUNKS) % 512 == 0 || idx < ROWS * CHUNKS) { const int r = idx / CHUNKS, c = idx % CHUNKS; *(LAS u32x4*)(dst + r * dstRS + c * 16) = v[it]; } }
}
namespace pg8 {
#define PG8_LAS __attribute__((address_space(3)))
typedef unsigned short bf16_t;
typedef short bf16x8 __attribute__((ext_vector_type(8)));
typedef float f32x4 __attribute__((ext_vector_type(4)));
typedef unsigned u32x4 __attribute__((ext_vector_type(4)));
constexpr int BM = 256, BK = 64, HALF = 128, HTB = HALF * BK * 2  , STAGE_BYTES = 8 * HTB, NXCD = 8, WGM = 8;

__host__ __device__ __forceinline__ int lds_byte(int r, int c) { const int st = (r >> 4) * 2 + (c >> 5), rr = r & 15, cc = c & 31, ob = rr * 64 + cc * 2; return st * 1024 + (ob ^ (((ob >> 9) & 1) << 5)); }
__host__ __device__ __forceinline__ void stage_rc(int b, int& R, int& C) { const int st = b / 1024, sb = b % 1024, swz = sb ^ (((sb >> 9) & 1) << 5); R = (st >> 1) * 16 + swz / 64; C = (st & 1) * 32 + (swz % 64) / 2; }
__host__ __device__ __forceinline__ int perm32(int rho) { const int n = rho >> 4, i = rho & 15; return 8 * (i >> 2) + 4 * n + (i & 3); }

struct Unit { int pm, pn; };
struct Gemm { const bf16_t* A; const bf16_t* Bt; int M, N, K; };

struct StaticOrder {
    int nM, nN, nwg, G, c;
    __host__ __device__ void init(int M, int N, int G_, int c_) { nM = M / BM; nN = N / BM; nwg = nM * nN; G = G_; c = c_; }
    __host__ __device__ bool next(int i, Unit& u) const {
        const long L = (long)i * G + c; if (L >= nwg) return false;
        int wgid = (int)L; { const int q = nwg / NXCD, r = nwg % NXCD, xcd = wgid % NXCD, off = wgid / NXCD; wgid = (xcd < r ? xcd * (q + 1) : r * (q + 1) + (xcd - r) * q) + off; }
        const int nig = WGM * nN, gid = wgid / nig, fm = gid * WGM, gsz = (nM - fm) < WGM ? (nM - fm) : WGM;
        u.pm = fm + ((wgid % nig) % gsz); u.pn = (wgid % nig) / gsz; return true;
    }
    __device__ __forceinline__ void a_ready(const Unit&) const {}
    __device__ __forceinline__ void done(const Unit&) const {}
};

__device__ __forceinline__ unsigned cvt_pk_bf16(float lo, float hi) { unsigned r; asm volatile("v_cvt_pk_bf16_f32 %0, %1, %2" : "=v"(r) : "v"(lo), "v"(hi)); return r; }
typedef float f32x2 __attribute__((ext_vector_type(2)));
struct EpiStore {
    static constexpr bool PERM = true, AFTER_DRAIN = false, RW = false;
    bf16_t* O; int ldc;
    __device__ __forceinline__ void operator()(const f32x4 (&acc)[2][2][4][2], const Unit& u, int wr, int wc, int fr, int fq) const {
        const int row0 = u.pm * BM + wr * 64 + fr, col0 = u.pn * BM + wc * 32 + 8 * fq;
#pragma unroll
        for (int ai = 0; ai < 2; ++ai)
#pragma unroll
            for (int m = 0; m < 4; ++m) { bf16_t* rowp = O + (size_t)(row0 + ai * HALF + m * 16) * ldc + col0;
#pragma unroll
                for (int bj = 0; bj < 2; ++bj) { const f32x4 v0 = acc[ai][bj][m][0], v1 = acc[ai][bj][m][1];
                    u32x4 w; w.x = cvt_pk_bf16(v0[0], v0[1]); w.y = cvt_pk_bf16(v0[2], v0[3]); w.z = cvt_pk_bf16(v1[0], v1[1]); w.w = cvt_pk_bf16(v1[2], v1[3]);
                    *(u32x4*)(rowp + bj * HALF) = w; } }
    }
};
struct EpiMerge {
    static constexpr bool PERM = true, AFTER_DRAIN = false, RW = true;
    const bf16_t* Hh; int ldh, mrg_col; const float* bmerge; bf16_t* MG;
    __device__ __forceinline__ bool rw(f32x4 (&acc)[2][2][4][2], const Unit& u, int wr, int wc, int fr, int fq) const {
        const int br = u.pm >> 6, pm = u.pm & 63, pn = u.pn & 15;
        const int row0 = pm * BM + wr * 64 + fr, col0 = pn * BM + wc * 32 + 8 * fq;
        const bool last = br == 2; const int brn = last ? 2 : br + 1;
#pragma unroll
        for (int bj = 0; bj < 2; ++bj) { const int col = col0 + bj * HALF;
            const f32x4 bd0 = *(const f32x4*)(bmerge + br * 4096 + col), bd1 = *(const f32x4*)(bmerge + br * 4096 + col + 4);
            const f32x4 bn0 = *(const f32x4*)(bmerge + brn * 4096 + col), bn1 = *(const f32x4*)(bmerge + brn * 4096 + col + 4);
#pragma unroll
            for (int ai = 0; ai < 2; ++ai)
#pragma unroll
                for (int m = 0; m < 4; ++m) { const int row = row0 + ai * HALF + m * 16;
                    const bf16_t* hp = Hh + (size_t)row * ldh + mrg_col + col;
                    const u32x4 gd = *(const u32x4*)(hp + br * 4096), gn = *(const u32x4*)(hp + brn * 4096);
                    const unsigned dw[4] = {gd.x, gd.y, gd.z, gd.w}, nw[4] = {gn.x, gn.y, gn.z, gn.w};
                    f32x4 f0, f1;
#pragma unroll
                    for (int j = 0; j < 4; ++j) {
                        const float d0 = ((j & 1) ? __uint_as_float(dw[j >> 1] & 0xffff0000u) : __uint_as_float(dw[j >> 1] << 16)) + bd0[j];
                        const float d1 = ((j & 1) ? __uint_as_float(dw[2 + (j >> 1)] & 0xffff0000u) : __uint_as_float(dw[2 + (j >> 1)] << 16)) + bd1[j];
                        const float n0 = ((j & 1) ? __uint_as_float(nw[j >> 1] & 0xffff0000u) : __uint_as_float(nw[j >> 1] << 16)) + bn0[j];
                        const float n1 = ((j & 1) ? __uint_as_float(nw[2 + (j >> 1)] & 0xffff0000u) : __uint_as_float(nw[2 + (j >> 1)] << 16)) + bn1[j];
                        const float num0 = last ? 1.f : 1.f + __expf(-n0), num1 = last ? 1.f : 1.f + __expf(-n1);
                        f0[j] = num0 / (1.f + __expf(-d0)); f1[j] = num1 / (1.f + __expf(-d1)); }
                    const f32x4 v0 = acc[ai][bj][m][0] * f0, v1 = acc[ai][bj][m][1] * f1;
                    acc[ai][bj][m][0] = v0; acc[ai][bj][m][1] = v1;
                    if (last) { u32x4 w; w.x = cvt_pk_bf16(v0[0], v0[1]); w.y = cvt_pk_bf16(v0[2], v0[3]); w.z = cvt_pk_bf16(v1[0], v1[1]); w.w = cvt_pk_bf16(v1[2], v1[3]);
                        *(u32x4*)(MG + (size_t)row * 4096 + col) = w; } } }
        return !last;
    }
};
struct EpiOut {
    static constexpr bool PERM = false, AFTER_DRAIN = false, RW = false;
    const float* X; float* C; float alpha;
    __device__ __forceinline__ void operator()(const f32x4 (&acc)[2][2][4][2], const Unit& u, int wr, int wc, int fr, int fq) const {
        const int row0 = u.pm * BM + wr * 64 + fr, col0 = u.pn * BM + wc * 32 + 4 * fq;
#pragma unroll
        for (int ai = 0; ai < 2; ++ai)
#pragma unroll
            for (int m = 0; m < 4; ++m) { const size_t off = (size_t)(row0 + ai * HALF + m * 16) * 4096 + col0;
#pragma unroll
                for (int bj = 0; bj < 2; ++bj)
#pragma unroll
                    for (int n = 0; n < 2; ++n) { const f32x4 xv = *(const f32x4*)(X + off + bj * HALF + n * 16); *(f32x4*)(C + off + bj * HALF + n * 16) = xv * alpha + acc[ai][bj][m][n]; } }
    }
};
struct MergeOrder {
    StaticOrder so;
    __host__ __device__ void init(int G_, int c_) { so.init(16384, 4096, G_, c_); }
    __host__ __device__ bool next(int i, Unit& u) const { Unit t; if (!so.next(i / 3, t)) return false; const int br = i % 3; u.pm = br * 64 + t.pm; u.pn = br * 16 + t.pn; return true; }
    __device__ __forceinline__ void a_ready(const Unit&) const {}
    __device__ __forceinline__ void done(const Unit&) const {}
};
struct H1Order {
    StaticOrder so;
    __host__ __device__ void init(int G_, int c_) { so.init(16384, 29952, G_, c_); }
    __host__ __device__ bool next(int i, Unit& u) const { if (so.next(i, u)) return true; const long e = (long)i * so.G + so.c - so.nwg; if (e < 32) { u.pm = 64 + (int)(e & 1); u.pn = 117 + (int)(e >> 1); return true; } return false; }
    __device__ __forceinline__ void a_ready(const Unit&) const {}
    __device__ __forceinline__ void done(const Unit&) const {}
};
struct EpiH1 {
    static constexpr bool PERM = true, AFTER_DRAIN = false, RW = false;
    bf16_t* O; int ldc; bf16_t* O2; int ldc2;
    __device__ __forceinline__ void operator()(const f32x4 (&acc)[2][2][4][2], const Unit& u, int wr, int wc, int fr, int fq) const {
        const bool ex = u.pm >= 64; bf16_t* base = ex ? O2 : O; const int ld = ex ? ldc2 : ldc;
        const int row0 = (ex ? u.pm - 64 : u.pm) * BM + wr * 64 + fr, col0 = (ex ? u.pn - 117 : u.pn) * BM + wc * 32 + 8 * fq;
#pragma unroll
        for (int ai = 0; ai < 2; ++ai)
#pragma unroll
            for (int m = 0; m < 4; ++m) { bf16_t* rowp = base + (size_t)(row0 + ai * HALF + m * 16) * ld + col0;
#pragma unroll
                for (int bj = 0; bj < 2; ++bj) { const f32x4 v0 = acc[ai][bj][m][0], v1 = acc[ai][bj][m][1];
                    u32x4 w; w.x = cvt_pk_bf16(v0[0], v0[1]); w.y = cvt_pk_bf16(v0[2], v0[3]); w.z = cvt_pk_bf16(v1[0], v1[1]); w.w = cvt_pk_bf16(v1[2], v1[3]);
                    *(u32x4*)(rowp + bj * HALF) = w; } }
    }
};
template <class Epi, class Sched, bool ALIGN_EPI = false, bool SP2 = false>
__device__ __forceinline__ void gemm_phase(PG8_LAS unsigned char* lds, const Gemm g, const Sched& S, const Epi& E) {
    const int tid = threadIdx.x, wid = __builtin_amdgcn_readfirstlane(tid >> 6), lane = tid & 63, wr = wid >> 2, wc = wid & 3, fr = lane & 15, fq = lane >> 4;
    const int K = g.K, nt = K / BK;
    unsigned voffA[2], voffB[2];
#pragma unroll
    for (int i = 0; i < 2; ++i) { int R, C; stage_rc(tid * 16 + i * 8192, R, C); const int Rb = Epi::PERM ? ((R & ~31) + perm32(R & 31)) : R;
        voffA[i] = (unsigned)(R * K + C) * 2u; voffB[i] = (unsigned)(Rb * K + C) * 2u; }
    const size_t kstep = (size_t)(BK * 2);
    const size_t hstep = (size_t)HALF * K * 2;
    const size_t tstep = 2 * hstep;
    const unsigned ldsw = (unsigned)wid * 1024u;
    const int aoff = lds_byte(wr * 64 + fr, fq * 8), boff = lds_byte(wc * 32 + fr, fq * 8);
#define PG8_SA(b, h) (((b) * 2 + (h)) * HTB)
#define PG8_SB(b, h) ((4 + (b) * 2 + (h)) * HTB)
#define PG8_STAGE(bufoff, gbase, voff) do { _Pragma("unroll") for (int _i = 0; _i < 2; ++_i) \
        __builtin_amdgcn_global_load_lds((const unsigned*)((const char*)(gbase) + (voff)[_i]), (PG8_LAS unsigned*)(lds + (bufoff) + ldsw + _i * 8192), 16, 0, 0); } while (0)
#define PG8_LDA(dst, b, h) do { _Pragma("unroll") for (int m = 0; m < 4; ++m) _Pragma("unroll") for (int k = 0; k < 2; ++k) dst[m][k] = *(const PG8_LAS bf16x8*)(lds + PG8_SA(b, h) + aoff + m * 2048 + k * 1024); } while (0)
#define PG8_LDB(dst, b, h) do { _Pragma("unroll") for (int n = 0; n < 2; ++n) _Pragma("unroll") for (int k = 0; k < 2; ++k) dst[n][k] = *(const PG8_LAS bf16x8*)(lds + PG8_SB(b, h) + boff + n * 2048 + k * 1024); } while (0)
#define PG8_MMA(ai, bj, At, Bt) do { __builtin_amdgcn_s_setprio(1); _Pragma("unroll") for (int m = 0; m < 4; ++m) _Pragma("unroll") for (int n = 0; n < 2; ++n) _Pragma("unroll") for (int k = 0; k < 2; ++k) \
        acc[ai][bj][m][n] = __builtin_amdgcn_mfma_f32_16x16x32_bf16(Bt[n][k], At[m][k], acc[ai][bj][m][n], 0, 0, 0); __builtin_amdgcn_s_setprio(0); } while (0)
#define PG8_WAIT_V(n) asm volatile("s_waitcnt vmcnt(" #n ")" ::: "memory")
#define PG8_WAIT_L(n) asm volatile("s_waitcnt lgkmcnt(" #n ")" ::: "memory")
#define PG8_BAR __builtin_amdgcn_s_barrier()
#define PG8_SCHED __builtin_amdgcn_sched_barrier(0)
    Unit cur, nxt; int ui = 0;
    if (!S.next(0, cur)) return;
    f32x4 acc[2][2][4][2];
#pragma unroll
    for (int a = 0; a < 2; ++a)
#pragma unroll
        for (int b = 0; b < 2; ++b)
#pragma unroll
            for (int m = 0; m < 4; ++m)
#pragma unroll
                for (int n = 0; n < 2; ++n) acc[a][b][m][n] = (f32x4){0.f, 0.f, 0.f, 0.f};
    bf16x8 At[4][2], B0[2][2], B1[2][2];
    const char* cA = (const char*)g.A + (size_t)cur.pm * tstep; const char* cB = (const char*)g.Bt + (size_t)cur.pn * tstep;
    S.a_ready(cur);
    if constexpr (SP2) {
        PG8_STAGE(PG8_SB(0, 0), cB, voffB); PG8_STAGE(PG8_SB(0, 1), cB + hstep, voffB); PG8_STAGE(PG8_SA(0, 0), cA, voffA); PG8_STAGE(PG8_SA(0, 1), cA + hstep, voffA);
        if (wr == 1) PG8_BAR;
        PG8_WAIT_V(2); PG8_BAR;
        PG8_STAGE(PG8_SB(1, 0), cB + kstep, voffB); PG8_STAGE(PG8_SA(1, 0), cA + kstep, voffA); PG8_STAGE(PG8_SB(1, 1), cB + hstep + kstep, voffB);
        PG8_WAIT_V(6); PG8_BAR;
    } else {
        PG8_STAGE(PG8_SB(0, 0), cB, voffB); PG8_STAGE(PG8_SA(0, 0), cA, voffA); PG8_STAGE(PG8_SB(0, 1), cB + hstep, voffB); PG8_STAGE(PG8_SA(0, 1), cA + hstep, voffA);
        if (wr == 1) PG8_BAR;
        PG8_WAIT_V(4); PG8_BAR;
        PG8_STAGE(PG8_SB(1, 0), cB + kstep, voffB); PG8_STAGE(PG8_SA(1, 0), cA + kstep, voffA); PG8_STAGE(PG8_SB(1, 1), cB + hstep + kstep, voffB);
        PG8_WAIT_V(6); PG8_BAR;
    }
    for (;;) {
        const bool has_next = S.next(ui + 1, nxt);
        const char* nA = has_next ? (const char*)g.A + (size_t)nxt.pm * tstep : cA; const char* nB = has_next ? (const char*)g.Bt + (size_t)nxt.pn * tstep : cB;
        for (int t = 0; t < nt; t += 2) {
            const bool last = (t == nt - 2);
            const char* a1 = cA + (size_t)(t + 1) * kstep;
            const char* a2 = last ? nA : cA + (size_t)(t + 2) * kstep; const char* b2 = last ? nB : cB + (size_t)(t + 2) * kstep;
            const char* a3 = a2 + kstep; const char* b3 = b2 + kstep;
            if (last && has_next) S.a_ready(nxt);
            if constexpr (SP2) {
            PG8_LDB(B0, 0, 0); PG8_LDB(B1, 0, 1); PG8_SCHED; PG8_LDA(At, 0, 0); PG8_STAGE(PG8_SA(1, 1), a1 + hstep, voffA);
            PG8_WAIT_V(8); PG8_WAIT_L(0); PG8_BAR; PG8_MMA(0, 0, At, B0); PG8_MMA(0, 1, At, B1); PG8_BAR; PG8_SCHED;
            PG8_LDA(At, 0, 1); PG8_STAGE(PG8_SB(0, 0), b2, voffB); PG8_STAGE(PG8_SB(0, 1), b2 + hstep, voffB); PG8_STAGE(PG8_SA(0, 0), a2, voffA);
            PG8_WAIT_V(8); PG8_WAIT_L(0); PG8_BAR; PG8_MMA(1, 0, At, B0); PG8_MMA(1, 1, At, B1); PG8_BAR; PG8_SCHED;
            PG8_LDB(B0, 1, 0); PG8_LDB(B1, 1, 1); PG8_SCHED; PG8_LDA(At, 1, 0); PG8_STAGE(PG8_SA(0, 1), a2 + hstep, voffA);
            PG8_WAIT_V(8); PG8_WAIT_L(0); PG8_BAR; PG8_MMA(0, 0, At, B0); PG8_MMA(0, 1, At, B1); PG8_BAR; PG8_SCHED;
            PG8_LDA(At, 1, 1); PG8_STAGE(PG8_SB(1, 0), b3, voffB); PG8_STAGE(PG8_SB(1, 1), b3 + hstep, voffB); PG8_STAGE(PG8_SA(1, 0), a3, voffA);
            PG8_WAIT_V(8); PG8_WAIT_L(0); PG8_BAR; PG8_MMA(1, 0, At, B0); PG8_MMA(1, 1, At, B1); PG8_BAR; PG8_SCHED;
            } else {
            PG8_LDB(B0, 0, 0); PG8_SCHED; PG8_LDA(At, 0, 0); PG8_STAGE(PG8_SA(1, 1), a1 + hstep, voffA);
            PG8_WAIT_L(8); PG8_BAR; PG8_WAIT_L(0); PG8_MMA(0, 0, At, B0); PG8_BAR; PG8_SCHED;
            PG8_LDB(B1, 0, 1); PG8_STAGE(PG8_SB(0, 0), b2, voffB);
            PG8_BAR; PG8_WAIT_L(0); PG8_MMA(0, 1, At, B1); PG8_BAR;
            PG8_LDA(At, 0, 1); PG8_STAGE(PG8_SA(0, 0), a2, voffA);
            PG8_BAR; PG8_WAIT_L(0); PG8_MMA(1, 0, At, B0); PG8_BAR; PG8_SCHED;
            PG8_STAGE(PG8_SB(0, 1), b2 + hstep, voffB);
            PG8_WAIT_V(6); PG8_BAR; PG8_MMA(1, 1, At, B1); PG8_BAR;
            PG8_LDB(B0, 1, 0); PG8_SCHED; PG8_LDA(At, 1, 0); PG8_STAGE(PG8_SA(0, 1), a2 + hstep, voffA);
            PG8_WAIT_L(8); PG8_BAR; PG8_WAIT_L(0); PG8_MMA(0, 0, At, B0); PG8_BAR; PG8_SCHED;
            PG8_LDB(B1, 1, 1); PG8_STAGE(PG8_SB(1, 0), b3, voffB);
            PG8_BAR; PG8_WAIT_L(0); PG8_MMA(0, 1, At, B1); PG8_BAR;
            PG8_LDA(At, 1, 1); PG8_STAGE(PG8_SA(1, 0), a3, voffA);
            PG8_BAR; PG8_WAIT_L(0); PG8_MMA(1, 0, At, B0); PG8_BAR; PG8_SCHED;
            PG8_STAGE(PG8_SB(1, 1), b3 + hstep, voffB);
            PG8_WAIT_V(6); PG8_BAR; PG8_MMA(1, 1, At, B1); PG8_BAR;
            }
        }
        if constexpr (ALIGN_EPI) { if (wr == 0) PG8_BAR; }
        bool keep_acc = false;
        if constexpr (!Epi::AFTER_DRAIN) { if constexpr (Epi::RW) keep_acc = E.rw(acc, cur, wr, wc, fr, fq); else E(acc, cur, wr, wc, fr, fq); S.done(cur); }
        if (!has_next) break;
        if (!keep_acc) {
#pragma unroll
        for (int a = 0; a < 2; ++a)
#pragma unroll
            for (int b = 0; b < 2; ++b)
#pragma unroll
                for (int m = 0; m < 4; ++m)
#pragma unroll
                    for (int n = 0; n < 2; ++n) acc[a][b][m][n] = (f32x4){0.f, 0.f, 0.f, 0.f};
        }
        cur = nxt; cA = nA; cB = nB; ++ui;
        if constexpr (ALIGN_EPI) { if (wr == 1) PG8_BAR; }
    }
    PG8_WAIT_V(0);
    if constexpr (!ALIGN_EPI) { if (wr == 0) PG8_BAR; }
    PG8_BAR;
    if constexpr (Epi::AFTER_DRAIN) { E.fused(acc, cur, wr, wc, fr, fq, lds, wid, lane); S.done(cur); }
#undef PG8_SA
#undef PG8_SB
#undef PG8_STAGE
#undef PG8_LDA
#undef PG8_LDB
#undef PG8_MMA
#undef PG8_WAIT_V
#undef PG8_WAIT_L
#undef PG8_BAR
#undef PG8_SCHED
}
}
#define XB_TMO      128
#define XB_XCNT(j)  (256  + 64 * (j))
#define XB_XSUB(j)  (1280 + 64 * (j))
#define XB_XGEN(j)  (2304 + 64 * (j))
#define XB_TOP      3328
#define XB_TOPGEN   3392
#define XCD_BAR_WORDS 3456
#define XB_SPIN_CAP (1u << 18)

__device__ __forceinline__ unsigned xb_ld(unsigned* p)              { return __hip_atomic_load(p, __ATOMIC_RELAXED, __HIP_MEMORY_SCOPE_AGENT); }
__device__ __forceinline__ unsigned xb_add(unsigned* p, unsigned v) { return __hip_atomic_fetch_add(p, v, __ATOMIC_RELAXED, __HIP_MEMORY_SCOPE_AGENT); }
__device__ __forceinline__ unsigned xb_xcc_id() { return (unsigned)__builtin_amdgcn_s_getreg((3 << 11) | 20) & 0xFu; }
#define XB_SPIN(cond, bar) do { unsigned _sp = 0; while (cond) { __builtin_amdgcn_s_sleep(1); \
    if ((++_sp & 255u) == 0u) { if (xb_ld(&(bar)[XB_TMO])) break; if (_sp > XB_SPIN_CAP) { atomicAdd(&(bar)[XB_TMO], 1u); break; } } } } while (0)

struct XcdBarrier {
    unsigned* bar; unsigned x;
    volatile LAS unsigned* st;
};

__device__ __forceinline__ XcdBarrier xcd_barrier_post(unsigned* bar, volatile LAS unsigned* st) {
    XcdBarrier b; b.bar = bar; b.x = xb_xcc_id(); b.st = st;
    if (threadIdx.x == 0) (void)xb_add(&bar[XB_XCNT(b.x)], 1u);
    return b;
}
__device__ __forceinline__ void xcd_barrier_complete(unsigned* bar, unsigned x, unsigned& nloc, unsigned& nx) {
    const unsigned G = gridDim.x * gridDim.y * gridDim.z;
    unsigned sum, cnt, mine, sp = 0u;
    for (;;) {
        sum = 0u; cnt = 0u; mine = 0u;
#pragma unroll
        for (unsigned j = 0; j < 16; ++j) { const unsigned c = xb_ld(&bar[XB_XCNT(j)]); sum += c; cnt += (c > 0u) ? 1u : 0u; mine = (j == x) ? c : mine; }
        if (sum == G) break;
        __builtin_amdgcn_s_sleep(1);
        if ((++sp & 255u) == 0u) { if (xb_ld(&bar[XB_TMO])) break; if (sp > XB_SPIN_CAP) { atomicAdd(&bar[XB_TMO], 1u); break; } }
    }
    nloc = mine > 0u ? mine : 1u; nx = cnt > 0u ? cnt : 1u;
}

__device__ __forceinline__ void xcd_barrier(const XcdBarrier& b) {
    asm volatile("s_waitcnt vmcnt(0)" ::: "memory");
    __syncthreads();
    if (threadIdx.x == 0) {
        unsigned* bar = b.bar;
        __builtin_amdgcn_s_waitcnt(0);
        unsigned nloc = b.st[0], nx = b.st[1];
        if (nloc == 0u) { xcd_barrier_complete(bar, b.x, nloc, nx); b.st[0] = nloc; b.st[1] = nx; }
        const unsigned old = xb_add(&bar[XB_XSUB(b.x)], 1u);
        const unsigned gen = old / nloc;
        if (old + 1u == (gen + 1u) * nloc) {
            __builtin_amdgcn_fence(__ATOMIC_RELEASE, "agent");
            asm volatile("s_waitcnt vmcnt(0)" ::: "memory");
            const unsigned og = xb_add(&bar[XB_TOP], 1u);
            const unsigned tg = og / nx;
            if (og + 1u == (tg + 1u) * nx) xb_add(&bar[XB_TOPGEN], 1u);
            else XB_SPIN(xb_ld(&bar[XB_TOPGEN]) == tg, bar);
            __builtin_amdgcn_fence(__ATOMIC_ACQUIRE, "agent");
            xb_add(&bar[XB_XGEN(b.x)], 1u);
            asm volatile("s_waitcnt vmcnt(0)" ::: "memory");
        } else {
            XB_SPIN(xb_ld(&bar[XB_XGEN(b.x)]) == gen, bar);
            __builtin_amdgcn_fence(__ATOMIC_ACQUIRE, "agent");
            asm volatile("s_waitcnt vmcnt(0)" ::: "memory");
        }
    }
    __syncthreads();
}
#define LDS_WAIT() asm volatile("s_waitcnt lgkmcnt(0)" ::: "memory")
struct Frame {
    LAS unsigned char* lds;
    volatile LAS unsigned* MISC;
    gu32* ctl;
    int tid, lane, wave, G, bid;
    unsigned char* ws;
};
struct Args { const float* in[20]; float* out; unsigned char* ws; int ph_lo, ph_hi; };
#define IN_X(A) ((A).in[0])
#define IN_MEM(A) ((A).in[1])
#define IN_WIN(A) ((A).in[2])
#define IN_BMERGE(A) ((A).in[3])
#define IN_WA2(A) ((A).in[4])
#define IN_BA(A) ((A).in[5])
#define IN_NORMG(A) ((A).in[6])
#define IN_PEK(A) ((A).in[7])
#define IN_PEV(A) ((A).in[8])
#define IN_WK1(A) ((A).in[9])
#define IN_WK2(A) ((A).in[10])
#define IN_WV1(A) ((A).in[11])
#define IN_WV2(A) ((A).in[12])
#define IN_WKV(A) ((A).in[13])
#define IN_WOUT(A) ((A).in[17])
#define IN_LNG(A) ((A).in[18])
#define IN_LNB(A) ((A).in[19])
#define WSB(off) ((bf16*)(F.ws + (off)))
#define WSF(off) ((float*)(F.ws + (off)))

DI int wq_next(Frame& F, int cw) {
    __syncthreads();
    if (F.tid == 0) F.MISC[0] = __hip_atomic_fetch_add(F.ctl + cw, 1u, RLX_AGENT);
    __syncthreads();
    return (int)F.MISC[0];
}

template <class Map> DI void transpose_item(const float* W, int K, int Nsrc, bf16* WT, LAS float* scr, int kb, int nb, int lane, Map map) {
    const int k0 = 64 * kb, n0 = 64 * nb;
    const int c4 = lane & 15, kq = lane >> 4;
    const int ns = map(n0 + 4 * c4);
    f32x4 v[16];
#pragma unroll
    for (int it = 0; it < 16; ++it) v[it] = ns >= 0 ? *(const f32x4*)(W + (size_t)(k0 + 4 * it + kq) * Nsrc + ns) : (f32x4){0.f, 0.f, 0.f, 0.f};
#pragma unroll
    for (int it = 0; it < 16; ++it) { LAS float* p = scr + (4 * it + kq) * 65 + 4 * c4; p[0] = v[it][0]; p[1] = v[it][1]; p[2] = v[it][2]; p[3] = v[it][3]; }
    LDS_WAIT(); asm volatile("" ::: "memory");
    const int c = lane & 7;
#pragma unroll
    for (int j = 0; j < 8; ++j) { const int n = (lane >> 3) + 8 * j; const LAS float* s = scr + (8 * c) * 65 + n;
        u32x4 o; o.x = cvtpk(s[0 * 65], s[1 * 65]); o.y = cvtpk(s[2 * 65], s[3 * 65]); o.z = cvtpk(s[4 * 65], s[5 * 65]); o.w = cvtpk(s[6 * 65], s[7 * 65]);
        *(GAS u32x4*)(WT + (size_t)(n0 + n) * K + k0 + 8 * c) = o; }
    LDS_WAIT(); asm volatile("" ::: "memory");
}
struct IdMap { DI int operator()(int n) const { return n; } };
struct WinMap { DI int operator()(int n) const { return win_src_col(n); } };

DI void cvt_rows_bf16(const float* src, bf16* dst, size_t n8, size_t g0, size_t gstride) {
    for (size_t i = g0; i < n8; i += 4 * gstride) { f32x4 a[4], b[4];
#pragma unroll
        for (int u = 0; u < 4; ++u) { const size_t k = i + u * gstride; if (k < n8) { a[u] = ((const f32x4*)src)[2 * k]; b[u] = ((const f32x4*)src)[2 * k + 1]; } }
#pragma unroll
        for (int u = 0; u < 4; ++u) { const size_t k = i + u * gstride; if (k < n8) { u32x4 o; o.x = cvtpk(a[u][0], a[u][1]); o.y = cvtpk(a[u][2], a[u][3]); o.z = cvtpk(b[u][0], b[u][1]); o.w = cvtpk(b[u][2], b[u][3]); ((u32x4*)dst)[k] = o; } } }
}

DI void p0_prologue(Frame& F, const Args& A) {
    LAS float* scr = (LAS float*)(F.lds + F.wave * 16896);
    const int gw = F.bid * NWAVES + F.wave, NGW = F.G * NWAVES;
    constexpr int I_WIN = 64 * (NP / 64), I_KV = 64 * 64, I_BR = 32 * 64, I_OUT = 64 * 64, I_W1 = 64 * 2, I_W2 = 2 * 2;
    constexpr int NITEMS = I_WIN + I_KV + 3 * I_BR + I_OUT + 2 * I_W1 + 2 * I_W2;
    for (int it = gw; it < NITEMS; it += NGW) {
        int r = it;
        if (r < I_WIN) { transpose_item(IN_WIN(A), 4096, D_IN, WSB(WS_WINT), scr, r / (NP / 64), r % (NP / 64), F.lane, WinMap()); continue; } r -= I_WIN;
        if (r < I_KV) { transpose_item(IN_WKV(A), 4096, 4096, WSB(WS_WKVT), scr, r / 64, r % 64, F.lane, IdMap()); continue; } r -= I_KV;
        if (r < 3 * I_BR) { const int br = r / I_BR, q = r % I_BR; transpose_item(br == 0 ? A.in[14] : (br == 1 ? A.in[15] : A.in[16]), 2048, 4096, WSB(WS_WBRT) + (size_t)br * 4096 * 2048, scr, q / 64, q % 64, F.lane, IdMap()); continue; } r -= 3 * I_BR;
        if (r < I_OUT) { transpose_item(IN_WOUT(A), 4096, 4096, WSB(WS_WOUTT), scr, r / 64, r % 64, F.lane, IdMap()); continue; } r -= I_OUT;
        if (r < 2 * I_W1) { const int kv = r / I_W1, q = r % I_W1; transpose_item(kv ? IN_WV1(A) : IN_WK1(A), 4096, 128, WSB(WS_W1T) + (size_t)kv * 128 * 4096, scr, q / 2, q % 2, F.lane, IdMap()); continue; } r -= 2 * I_W1;
        { const int kv = r / I_W2, q = r % I_W2; transpose_item(kv ? IN_WV2(A) : IN_WK2(A), 128, 128, WSB(WS_W2T) + (size_t)kv * 128 * 128, scr, q / 2, q % 2, F.lane, IdMap()); }
    }
    const size_t gt = (size_t)F.bid * 512 + F.tid, GT = (size_t)F.G * 512;
    cvt_rows_bf16(IN_X(A), WSB(WS_XB), (size_t)M * DM / 8, gt, GT);
    cvt_rows_bf16(IN_MEM(A), WSB(WS_MEMB), (size_t)512 * DM / 8, gt, GT);
    for (int o = gw; o < 256; o += NGW) { const int kv = o >> 7, j = o & 127; const float* pe = kv ? IN_PEV(A) : IN_PEK(A); const float* w1 = kv ? IN_WV1(A) : IN_WK1(A);
        float s = 0.f; for (int k = F.lane; k < 4096; k += 64) s += pe[k] * w1[(size_t)k * 128 + j];
        s = wave_sum(s); if (F.lane == 0) WSF(WS_C1)[o] = s; }
}
DI void mem_attn_item(Frame& F, int item) {
    const int tile = item & 63, head = (item >> 6) & 3, b = item >> 8;
    int tid = F.tid; asm volatile("" : "+v"(tid)); const int lane = tid & 63, w = __builtin_amdgcn_readfirstlane(tid >> 6); const int i = lane & 15, g = lane >> 4;
    const int tok = b * SEQ + tile * 128 + 16 * w + i;
    LAS char* KL = (LAS char*)F.lds;
    LAS char* VL = (LAS char*)F.lds + 36864;
    const bf16* qrow = WSB(WS_H) + (size_t)tok * NP + H_MQ + head * 512;
    bf16x8 qf[16];
#pragma unroll
    for (int s = 0; s < 16; ++s) qf[s] = *(const bf16x8*)(qrow + 32 * s + 8 * g);
    f32x4 sacc[16];
#pragma unroll
    for (int kt = 0; kt < 16; ++kt) sacc[kt] = (f32x4){0.f, 0.f, 0.f, 0.f};
    const char* kbase = (const char*)(WSB(WS_KVMEM) + (size_t)(b * 256) * 4096 + head * 512);
#pragma unroll
    for (int dc = 0; dc < 8; ++dc) {
        lds_barrier();
        g2l_tile<256, 8>(KL, 144, kbase + dc * 128, 8192, tid);
        lds_barrier();
#pragma unroll
        for (int s2 = 0; s2 < 2; ++s2)
#pragma unroll
            for (int kt = 0; kt < 16; ++kt) { const bf16x8 a = *(const LAS bf16x8*)(KL + (16 * kt + i) * 144 + (s2 * 32 + 8 * g) * 2); sacc[kt] = mfma16(a, qf[dc * 2 + s2], sacc[kt]); }
    }
    const float scale = 0.04419417382415922f;
    float mx = NEG;
#pragma unroll
    for (int kt = 0; kt < 16; ++kt)
#pragma unroll
        for (int r = 0; r < 4; ++r) mx = fmaxf(mx, sacc[kt][r]);
    mx = fmaxf(mx, __shfl_xor(mx, 16)); mx = fmaxf(mx, __shfl_xor(mx, 32));
    float sum = 0.f;
#pragma unroll
    for (int kt = 0; kt < 16; ++kt)
#pragma unroll
        for (int r = 0; r < 4; ++r) { const float p = __expf((sacc[kt][r] - mx) * scale); sacc[kt][r] = p; sum += p; }
    sum += __shfl_xor(sum, 16); sum += __shfl_xor(sum, 32);
    const float inv = 1.f / sum;
    bf16x8 pf[8];
#pragma unroll
    for (int s = 0; s < 8; ++s) pf[s] = pack2(sacc[2 * s], sacc[2 * s + 1]);
    const char* vbase = (const char*)(WSB(WS_KVMEM) + (size_t)(b * 256) * 4096 + 2048 + head * 512);
    const bf16* zrow = WSB(WS_H) + (size_t)tok * NP + H_MZ + head * 512;
    bf16* orow = WSB(WS_GATED) + (size_t)2 * M * 2048 + (size_t)tok * 2048 + head * 512;
#pragma unroll 1
    for (int dcv = 0; dcv < 4; ++dcv) {
        lds_barrier();
        g2l_tile<256, 16>(VL, 288, vbase + dcv * 256, 8192, tid);
        lds_barrier();
        f32x4 oacc[8];
#pragma unroll
        for (int dt = 0; dt < 8; ++dt) oacc[dt] = (f32x4){0.f, 0.f, 0.f, 0.f};
#pragma unroll
        for (int s = 0; s < 8; ++s)
#pragma unroll
            for (int dt = 0; dt < 8; ++dt) { const bf16x8 a = tr_frag(VL, 288, 16 * dt, 32 * s + 4 * g, 32 * s + 16 + 4 * g, lane); oacc[dt] = mfma16(a, pf[s], oacc[dt]); }
#pragma unroll
        for (int dt = 0; dt < 8; ++dt) { const int d0 = dcv * 128 + 16 * dt + 4 * g;
            const u32x2 z = *(const u32x2*)(zrow + d0);
            const float o0 = oacc[dt][0] * inv * siluf_(bflo(z.x)), o1 = oacc[dt][1] * inv * siluf_(bfhi(z.x)), o2 = oacc[dt][2] * inv * siluf_(bflo(z.y)), o3 = oacc[dt][3] * inv * siluf_(bfhi(z.y));
            u32x2 o; o.x = cvtpk(o0, o1); o.y = cvtpk(o2, o3); *(u32x2*)(orow + d0) = o; }
    }
}

DI void compress_item(Frame& F, int item) {
    const int ntile = item & 3, g = (item >> 2) & 3, b = (item >> 4) & 1, kv = item >> 5;
    int tid = F.tid; asm volatile("" : "+v"(tid)); const int lane = tid & 63, w = __builtin_amdgcn_readfirstlane(tid >> 6); const int i = lane & 15, gq = lane >> 4; (void)tid;
    const int n = ntile * 128 + 16 * w + i, nn = n < 510 ? n : 510;
    const bf16* xbase = WSB(WS_H) + (size_t)(b * SEQ + 16 * nn) * NP + (kv ? H_NVC : H_NKC) + g * 128;
    const bf16* w1t = WSB(WS_W1T) + (size_t)kv * 128 * 4096;
    const bf16* w2t = WSB(WS_W2T) + (size_t)kv * 128 * 128;
    f32x4 acc[8];
#pragma unroll
    for (int jt = 0; jt < 8; ++jt) acc[jt] = *(const f32x4*)(WSF(WS_C1) + kv * 128 + 16 * jt + 4 * gq);
#pragma unroll 2
    for (int s = 0; s < 128; ++s) {
        const bf16x8 bx = *(const bf16x8*)(xbase + (size_t)(s >> 2) * NP + (s & 3) * 32 + 8 * gq);
#pragma unroll
        for (int jt = 0; jt < 8; ++jt) { const bf16x8 aw = *(const bf16x8*)(w1t + (size_t)(16 * jt + i) * 4096 + 32 * s + 8 * gq); acc[jt] = mfma16(aw, bx, acc[jt]); }
    }
#pragma unroll
    for (int jt = 0; jt < 8; ++jt)
#pragma unroll
        for (int r = 0; r < 4; ++r) acc[jt][r] = siluf_(acc[jt][r]);
    bf16x8 hf[4];
#pragma unroll
    for (int s = 0; s < 4; ++s) hf[s] = pack2(acc[2 * s], acc[2 * s + 1]);
    bf16* orow = WSB(WS_CMP) + ((size_t)((kv * 2 + b) * 4 + g) * 512 + n) * 128;
#pragma unroll
    for (int jt = 0; jt < 8; ++jt) {
        f32x4 o = (f32x4){0.f, 0.f, 0.f, 0.f};
#pragma unroll
        for (int s = 0; s < 4; ++s) { const bf16* wr_ = w2t + (size_t)(16 * jt + i) * 128 + 32 * s + 4 * gq;
            const s16x4 lo = *(const s16x4*)wr_, hi = *(const s16x4*)(wr_ + 16);
            const bf16x8 aw = __builtin_shufflevector(lo, hi, 0, 1, 2, 3, 4, 5, 6, 7);
            o = mfma16(aw, hf[s], o); }
        u32x2 ov; if (n <= 510) { ov.x = cvtpk(o[0], o[1]); ov.y = cvtpk(o[2], o[3]); } else { ov.x = 0u; ov.y = 0u; }
        *(u32x2*)(orow + 16 * jt + 4 * gq) = ov;
    }
}
DI void gla_prep_item(Frame& F, const Args& A, int item) {
    const int n = item & 127, h = (item >> 7) & 3, b = item >> 9;
    const int tok0 = b * SEQ + 64 * n;
    int tid = F.tid; asm volatile("" : "+v"(tid)); const int lane = tid & 63, w = __builtin_amdgcn_readfirstlane(tid >> 6); const int i = lane & 15, g = lane >> 4;
    LAS float* LA = (LAS float*)F.lds;
    LAS char* VL = (LAS char*)F.lds;
    LAS char* QL = (LAS char*)F.lds + 67584;
    LAS char* KL = (LAS char*)F.lds + 101376;
    LAS float* GA = (LAS float*)(F.lds + 135168);
    LAS u32x4* ATT = (LAS u32x4*)(F.lds + 139264);
    if (tid < 128) { const int c = tid >> 1, hf = tid & 1; const u32x4 v = *(const u32x4*)(WSB(WS_H) + (size_t)(tok0 + c) * NP + H_SM + 8 * hf);
        LAS float* gp = GA + c * 16 + 8 * hf; gp[0] = bflo(v.x); gp[1] = bfhi(v.x); gp[2] = bflo(v.y); gp[3] = bfhi(v.y); gp[4] = bflo(v.z); gp[5] = bfhi(v.z); gp[6] = bflo(v.w); gp[7] = bfhi(v.w); }
    lds_barrier();
    { const int d = tid & 255, hf = tid >> 8; float wa[16];
#pragma unroll
      for (int j = 0; j < 16; ++j) wa[j] = IN_WA2(A)[j * 1024 + h * 256 + d];
      const float ba = IN_BA(A)[h * 256 + d]; float run = 0.f;
      for (int cc = 0; cc < 32; ++cc) { const int c = hf * 32 + cc; float lg = ba;
#pragma unroll
          for (int j = 0; j < 16; ++j) lg += GA[c * 16 + j] * wa[j];
          const float ls = -(fmaxf(-lg, 0.f) + __logf(1.f + __expf(-fabsf(lg))));
          run += ls * 0.0625f; LA[c * 256 + d] = run; } }
    lds_barrier();
#pragma unroll 1
    for (int it = 0; it < 4; ++it) { const int u = tid + 512 * it, c = u >> 5, d0 = (u & 31) * 8;
        const u32x4 qv = *(const u32x4*)(WSB(WS_H) + (size_t)(tok0 + c) * NP + H_GQ + h * 256 + d0);
        const u32x4 kv = *(const u32x4*)(WSB(WS_H) + (size_t)(tok0 + c) * NP + H_GK + h * 256 + d0);
        const unsigned qw[4] = {qv.x, qv.y, qv.z, qv.w}, kw[4] = {kv.x, kv.y, kv.z, kv.w};
        float qd[8], kd[8], ke[8];
#pragma unroll
        for (int e = 0; e < 8; ++e) { const int d = d0 + e; const float o31 = LA[31 * 256 + d], bl = LA[63 * 256 + d] + o31, bc = LA[c * 256 + d] + (c >= 32 ? o31 : 0.f);
            const float qq = (e & 1) ? bfhi(qw[e >> 1]) : bflo(qw[e >> 1]), kk = (e & 1) ? bfhi(kw[e >> 1]) : bflo(kw[e >> 1]);
            qd[e] = qq * 0.0625f * __expf(bc); kd[e] = kk * __expf(-bc); ke[e] = kk * __expf(bl - bc);
            if (c == 63) WSF(WS_GDEC)[(size_t)item * 256 + d] = __expf(bl); }
        u32x4 o; o.x = cvtpk(qd[0], qd[1]); o.y = cvtpk(qd[2], qd[3]); o.z = cvtpk(qd[4], qd[5]); o.w = cvtpk(qd[6], qd[7]); *(LAS u32x4*)(QL + c * 528 + d0 * 2) = o;
        o.x = cvtpk(kd[0], kd[1]); o.y = cvtpk(kd[2], kd[3]); o.z = cvtpk(kd[4], kd[5]); o.w = cvtpk(kd[6], kd[7]); *(LAS u32x4*)(KL + c * 528 + d0 * 2) = o;
        o.x = cvtpk(ke[0], ke[1]); o.y = cvtpk(ke[2], ke[3]); o.z = cvtpk(ke[4], ke[5]); o.w = cvtpk(ke[6], ke[7]); *(u32x4*)(WSB(WS_KEND) + (size_t)(tok0 + c) * 1024 + h * 256 + d0) = o; }
    lds_barrier();
#pragma unroll 1
    for (int it = 0; it < 4; ++it) { const int u = tid + 512 * it, c = u >> 5, pc = u & 31, g32 = pc >> 2, gg = pc & 3;
        const u32x2 lo = *(const LAS u32x2*)(QL + c * 528 + (32 * g32 + 4 * gg) * 2), hi = *(const LAS u32x2*)(QL + c * 528 + (32 * g32 + 16 + 4 * gg) * 2);
        u32x4 o; o.x = lo.x; o.y = lo.y; o.z = hi.x; o.w = hi.y; *(u32x4*)(WSB(WS_QD) + (size_t)(tok0 + c) * 1024 + h * 256 + 8 * pc) = o; }
    { const int ct = w & 3, jp = w >> 2; f32x4 a0 = (f32x4){0.f, 0.f, 0.f, 0.f}, a1 = a0;
#pragma unroll
      for (int s = 0; s < 8; ++s) { const bf16x8 bq = *(const LAS bf16x8*)(QL + (16 * ct + i) * 528 + (32 * s + 8 * g) * 2);
          const bf16x8 k0 = *(const LAS bf16x8*)(KL + (32 * jp + i) * 528 + (32 * s + 8 * g) * 2), k1 = *(const LAS bf16x8*)(KL + (32 * jp + 16 + i) * 528 + (32 * s + 8 * g) * 2);
          a0 = mfma16(k0, bq, a0); a1 = mfma16(k1, bq, a1); }
      const int c = 16 * ct + i;
#pragma unroll
      for (int r = 0; r < 4; ++r) { if (32 * jp + 4 * g + r > c) a0[r] = 0.f; if (32 * jp + 16 + 4 * g + r > c) a1[r] = 0.f; }
      ATT[(ct * 2 + jp) * 64 + lane] = __builtin_bit_cast(u32x4, pack2(a0, a1)); }
    lds_barrier();
    g2l_tile<64, 64>(VL, 1056, (const char*)(WSB(WS_H) + (size_t)tok0 * NP + H_GV + h * 512), (size_t)NP * 2, tid);
    lds_barrier();
    { f32x4 acc[4][4];
#pragma unroll
      for (int et = 0; et < 4; ++et)
#pragma unroll
          for (int ct = 0; ct < 4; ++ct) acc[et][ct] = (f32x4){0.f, 0.f, 0.f, 0.f};
#pragma unroll
      for (int s = 0; s < 2; ++s) { bf16x8 bfr[4];
#pragma unroll
          for (int ct = 0; ct < 4; ++ct) bfr[ct] = __builtin_bit_cast(bf16x8, ATT[(ct * 2 + s) * 64 + lane]);
#pragma unroll
          for (int et = 0; et < 4; ++et) { const bf16x8 a = tr_frag(VL, 1056, 64 * w + 16 * et, 32 * s + 4 * g, 32 * s + 16 + 4 * g, lane);
#pragma unroll
              for (int ct = 0; ct < 4; ++ct) acc[et][ct] = mfma16(a, bfr[ct], acc[et][ct]); } }
#pragma unroll
      for (int et = 0; et < 4; ++et)
#pragma unroll
          for (int ct = 0; ct < 4; ++ct) *(f32x4*)(WSF(WS_GO) + (size_t)(tok0 + 16 * ct + i) * 2048 + h * 512 + 64 * w + 16 * et + 4 * g) = acc[et][ct]; }
    lds_barrier();
}

DI void gla_scan_item(Frame& F, int item) {
    const int es = item & 3, h = (item >> 2) & 3, b = item >> 4;
    int tid = F.tid; asm volatile("" : "+v"(tid)); const int lane = tid & 63, w = __builtin_amdgcn_readfirstlane(tid >> 6); const int i = lane & 15, g = lane >> 4;
    const int dh = w >> 2, eq = w & 3;
    LAS char* QL = (LAS char*)F.lds;
    LAS char* KL = (LAS char*)F.lds + 33792;
    LAS char* VL = (LAS char*)F.lds + 68608;
    LAS float* GD = (LAS float*)(F.lds + 87040);
    LAS f32x4* RED = (LAS f32x4*)(F.lds + 88064);
    f32x4 S[8][2];
#pragma unroll
    for (int dt = 0; dt < 8; ++dt) { S[dt][0] = (f32x4){0.f, 0.f, 0.f, 0.f}; S[dt][1] = (f32x4){0.f, 0.f, 0.f, 0.f}; }
    u32x4 pq[4], pk[4], pv[2], pg[1];
    const size_t tokb = (size_t)b * SEQ;
    const int ecol = h * 512 + es * 128;
    pf_load<64, 32>(pq, (const char*)(WSB(WS_QD) + tokb * 1024 + h * 256), 2048, tid);
    pf_load<64, 32>(pk, (const char*)(WSB(WS_KEND) + tokb * 1024 + h * 256), 2048, tid);
    pf_load<64, 16>(pv, (const char*)(WSB(WS_H) + tokb * NP + H_GV + ecol), (size_t)NP * 2, tid);
    pf_load<1, 64>(pg, (const char*)(WSF(WS_GDEC) + (size_t)((b * 4 + h) * 128) * 256), 0, tid);
#pragma unroll 1
    for (int n = 0; n < 128; ++n) {
        lds_barrier();
        pf_store<64, 32>(pq, QL, 528, tid); pf_store<64, 32>(pk, KL, 544, tid); pf_store<64, 16>(pv, VL, 288, tid); pf_store<1, 64>(pg, (LAS char*)GD, 0, tid);
        lds_barrier();
        const size_t tok0 = tokb + 64 * n;
        if (n + 1 < 128) { const size_t t1 = tok0 + 64;
            pf_load<64, 32>(pq, (const char*)(WSB(WS_QD) + t1 * 1024 + h * 256), 2048, tid);
            pf_load<64, 32>(pk, (const char*)(WSB(WS_KEND) + t1 * 1024 + h * 256), 2048, tid);
            pf_load<64, 16>(pv, (const char*)(WSB(WS_H) + t1 * NP + H_GV + ecol), (size_t)NP * 2, tid);
            pf_load<1, 64>(pg, (const char*)(WSF(WS_GDEC) + (size_t)((b * 4 + h) * 128 + n + 1) * 256), 0, tid); }
        f32x4 oa[2][4];
#pragma unroll
        for (int et = 0; et < 2; ++et)
#pragma unroll
            for (int ct = 0; ct < 4; ++ct) oa[et][ct] = (f32x4){0.f, 0.f, 0.f, 0.f};
#pragma unroll
        for (int s = 0; s < 4; ++s) { const bf16x8 a0 = pack2(S[2 * s][0], S[2 * s + 1][0]), a1 = pack2(S[2 * s][1], S[2 * s + 1][1]);
#pragma unroll
            for (int ct = 0; ct < 4; ++ct) { const bf16x8 bq = *(const LAS bf16x8*)(QL + (16 * ct + i) * 528 + (128 * dh + 32 * s + 8 * g) * 2); oa[0][ct] = mfma16(a0, bq, oa[0][ct]); oa[1][ct] = mfma16(a1, bq, oa[1][ct]); } }
#pragma unroll
        for (int ct = 0; ct < 4; ++ct) RED[(w * 4 + ct) * 64 + lane] = dh ? oa[0][ct] : oa[1][ct];
#pragma unroll
        for (int dt = 0; dt < 8; ++dt) { const f32x4 gd = *(const LAS f32x4*)(GD + 128 * dh + 16 * dt + 4 * g); S[dt][0] = S[dt][0] * gd; S[dt][1] = S[dt][1] * gd; }
        lds_barrier();
#pragma unroll
        for (int ct = 0; ct < 4; ++ct) { const f32x4 mine = dh ? oa[1][ct] : oa[0][ct]; const f32x4 o = mine + RED[((w ^ 4) * 4 + ct) * 64 + lane];
            *(f32x4*)(WSF(WS_GO2) + (tok0 + 16 * ct + i) * 2048 + ecol + 32 * eq + 16 * dh + 4 * g) = o; }
#pragma unroll
        for (int s = 0; s < 2; ++s) { const bf16x8 bv0 = tr_frag(VL, 288, 32 * eq, 32 * s + 4 * g, 32 * s + 16 + 4 * g, lane), bv1 = tr_frag(VL, 288, 32 * eq + 16, 32 * s + 4 * g, 32 * s + 16 + 4 * g, lane);
#pragma unroll
            for (int dt = 0; dt < 8; ++dt) { const bf16x8 a = tr_frag(KL, 544, 128 * dh + 16 * dt, 32 * s + 4 * g, 32 * s + 16 + 4 * g, lane); S[dt][0] = mfma16(a, bv0, S[dt][0]); S[dt][1] = mfma16(a, bv1, S[dt][1]); } }
    }
    lds_barrier();
}

DI void gla_finalize(Frame& F, const Args& A) {
    const int gw = F.bid * NWAVES + F.wave, NGW = F.G * NWAVES, lane = F.lane;
    const f32x4 g0 = *(const f32x4*)(IN_NORMG(A) + 8 * lane), g1 = *(const f32x4*)(IN_NORMG(A) + 8 * lane + 4);
    for (int idx = gw; idx < M * 4; idx += NGW) { const int tok = idx >> 2, h = idx & 3;
        const float* op = WSF(WS_GO) + (size_t)tok * 2048 + h * 512 + 8 * lane; const float* op2 = WSF(WS_GO2) + (size_t)tok * 2048 + h * 512 + 8 * lane;
        const f32x4 a = *(const f32x4*)op + *(const f32x4*)op2, c = *(const f32x4*)(op + 4) + *(const f32x4*)(op2 + 4);
        float ss = a[0] * a[0] + a[1] * a[1] + a[2] * a[2] + a[3] * a[3] + c[0] * c[0] + c[1] * c[1] + c[2] * c[2] + c[3] * c[3];
        ss = wave_sum(ss);
        const float rs = rsqrtf(ss * (1.f / 512.f) + RMS_EPS);
        const u32x4 z = *(const u32x4*)(WSB(WS_H) + (size_t)tok * NP + H_GZ + h * 512 + 8 * lane);
        u32x4 o;
        o.x = cvtpk(a[0] * rs * g0[0] * siluf_(bflo(z.x)), a[1] * rs * g0[1] * siluf_(bfhi(z.x)));
        o.y = cvtpk(a[2] * rs * g0[2] * siluf_(bflo(z.y)), a[3] * rs * g0[3] * siluf_(bfhi(z.y)));
        o.z = cvtpk(c[0] * rs * g1[0] * siluf_(bflo(z.z)), c[1] * rs * g1[1] * siluf_(bfhi(z.z)));
        o.w = cvtpk(c[2] * rs * g1[2] * siluf_(bflo(z.w)), c[3] * rs * g1[3] * siluf_(bfhi(z.w)));
        *(u32x4*)(WSB(WS_GATED) + (size_t)tok * 2048 + h * 512 + 8 * lane) = o; }
}
DI void qk_tile(f32x4 (&sacc)[4], const LAS char* KL, const bf16x8 (&qf)[4], int i, int grp) {
#pragma unroll
    for (int kt = 0; kt < 4; ++kt) sacc[kt] = (f32x4){0.f, 0.f, 0.f, 0.f};
#pragma unroll
    for (int sh = 0; sh < 2; ++sh) { bf16x8 ak[2][4];
#pragma unroll
        for (int ss = 0; ss < 2; ++ss)
#pragma unroll
            for (int kt = 0; kt < 4; ++kt) ak[ss][kt] = *(const LAS bf16x8*)(KL + (16 * kt + i) * 272 + (32 * (2 * sh + ss) + 8 * grp) * 2);
        __builtin_amdgcn_sched_barrier(0);
#pragma unroll
        for (int ss = 0; ss < 2; ++ss)
#pragma unroll
            for (int kt = 0; kt < 4; ++kt) sacc[kt] = mfma16(ak[ss][kt], qf[2 * sh + ss], sacc[kt]);
    }
}
DI void pv_tile(f32x4 (&oacc)[8], const LAS char* VL, const bf16x8 (&pf)[2], int lane, int grp) {
#pragma unroll
    for (int s2 = 0; s2 < 2; ++s2) { bf16x8 av[8];
#pragma unroll
        for (int dt = 0; dt < 8; ++dt) av[dt] = tr_frag(VL, 288, 16 * dt, 32 * s2 + 4 * grp, 32 * s2 + 16 + 4 * grp, lane);
        __builtin_amdgcn_sched_barrier(0);
#pragma unroll
        for (int dt = 0; dt < 8; ++dt) oacc[dt] = mfma16(av[dt], pf[s2], oacc[dt]);
    }
}
constexpr float NEGS = -1e30f, MINIT = -1e20f;
template <bool MASKED> DI void score_tile(f32x4 (&sacc)[4], float sc2, float slk, float c0, int dl, unsigned lim) {
#pragma unroll
    for (int kt = 0; kt < 4; ++kt)
#pragma unroll
        for (int r = 0; r < 4; ++r) { const int ko = 16 * kt + r; float x = fmaf(sacc[kt][r], sc2, fmaf(slk, (float)ko, c0));
            if (MASKED) x = ((unsigned)(dl - ko) < lim) ? x : NEGS;
            sacc[kt][r] = x; }
}
DI float tile_max(const f32x4 (&sacc)[4]) {
    float tm = fmaxf(fmaxf(sacc[0][0], sacc[0][1]), fmaxf(sacc[0][2], sacc[0][3]));
#pragma unroll
    for (int kt = 1; kt < 4; ++kt) tm = fmaxf(tm, fmaxf(fmaxf(sacc[kt][0], sacc[kt][1]), fmaxf(sacc[kt][2], sacc[kt][3])));
    tm = fmaxf(tm, __shfl_xor(tm, 16)); tm = fmaxf(tm, __shfl_xor(tm, 32));
    return tm;
}
DI void online_tile(f32x4 (&sacc)[4], float& m, float& l, f32x4 (&oacc)[8], const LAS char* VL, int lane, int grp) {
    const float mn = fmaxf(m, tile_max(sacc)), alpha = __builtin_amdgcn_exp2f(m - mn);
    float ps = 0.f;
#pragma unroll
    for (int kt = 0; kt < 4; ++kt)
#pragma unroll
        for (int r = 0; r < 4; ++r) { const float p = __builtin_amdgcn_exp2f(sacc[kt][r] - mn); sacc[kt][r] = p; ps += p; }
    l = l * alpha + ps; m = mn;
#pragma unroll
    for (int dt = 0; dt < 8; ++dt) oacc[dt] = oacc[dt] * alpha;
    bf16x8 pf[2]; pf[0] = pack2(sacc[0], sacc[1]); pf[1] = pack2(sacc[2], sacc[3]);
    pv_tile(oacc, VL, pf, lane, grp);
}

DI void nsa_attend_item(Frame& F, int item) {
    const int qt = 255 - (item & 255), g = (item >> 8) & 3, b = item >> 10;
    int tid = F.tid; asm volatile("" : "+v"(tid)); const int lane = tid & 63, w = __builtin_amdgcn_readfirstlane(tid >> 6); const int i = lane & 15, grp = lane >> 4, ql = i >> 2, r4 = i & 3;
    const int t0 = 32 * qt, qi = 4 * w + ql, t = t0 + qi, head = 4 * g + r4;
    const size_t tok = (size_t)b * SEQ + t;
    const float sl2 = exp2f(-0.5f * (float)(head + 1)) * 1.4426950408889634f;
    const float sc2 = 0.08838834764831845f * 1.4426950408889634f;
    LAS char* const L0 = (LAS char*)F.lds;
#define NSA_KL(c) (L0 + (c) * 35840)
#define NSA_VL(c) (L0 + (c) * 35840 + 17408)
    LAS float* IMPA = (LAS float*)(F.lds + 71680);
    LAS float* IMPB = (LAS float*)(F.lds + 88064);
    LAS unsigned* SELM = (LAS unsigned*)(F.lds + 104448);
    bf16x8 qf[4];
    { const bf16* qrow = WSB(WS_H) + tok * NP + H_NQ + head * 128;
#pragma unroll
      for (int s = 0; s < 4; ++s) qf[s] = *(const bf16x8*)(qrow + 32 * s + 8 * grp); }
    float gate[3];
#pragma unroll
    for (int br = 0; br < 3; ++br) gate[br] = sigmoidf_(bf2f(WSB(WS_H)[tok * NP + H_SM + 16 + head * 3 + br]));
    f32x4 comb[8], oacc[8], sacc[4];
    u32x4 rk[2], rv[2];
#pragma unroll
    for (int dt = 0; dt < 8; ++dt) comb[dt] = (f32x4){0.f, 0.f, 0.f, 0.f};

    const int cnt_t = t >= 31 ? ((t - 31) >> 4) + 1 : 0;
    const int ntile = (2 * qt + 1 + 63) >> 6;
    const char* kcb = (const char*)(WSB(WS_CMP) + (size_t)((0 * 2 + b) * 4 + g) * 512 * 128);
    const char* vcb = (const char*)(WSB(WS_CMP) + (size_t)((1 * 2 + b) * 4 + g) * 512 * 128);
    const int cur = t0 >> 6;
    const char* const hb = (const char*)(WSB(WS_H) + (size_t)b * SEQ * NP + g * 128);
    const int jlo = t0 >= 511 ? (t0 - 511) >> 6 : 0;
    int cbuf = 0;
    pf_load<64, 16>(rk, kcb, 256, tid);
    for (int u = tid; u < 8192; u += 512) IMPA[u] = 0.f;
    pf_store<64, 16>(rk, NSA_KL(0), 272, tid);
    lds_barrier();
    const int cnt_min = t0 >= 31 ? ((t0 - 31) >> 4) + 1 : 0;
    float m = MINIT, l = 0.f;
#pragma unroll 1
    for (int T = 0; T < ntile; ++T) { const int cb = cbuf; const bool hn = T + 1 < ntile;
        if (hn) pf_load<64, 16>(rk, kcb + (size_t)(T + 1) * 64 * 256, 256, tid); else { pf_load<64, 16>(rk, kcb, 256, tid); pf_load<64, 16>(rv, vcb, 256, tid); }
        qk_tile(sacc, NSA_KL(cb), qf, i, grp);
        { const int nb = 64 * T + 4 * grp; const float c0 = -sl2 * (float)(t - 31 - 16 * nb);
          if (64 * T + 63 < cnt_min) score_tile<false>(sacc, sc2, 16.f * sl2, c0, 0, 0u); else score_tile<true>(sacc, sc2, 16.f * sl2, c0, cnt_t - 1 - nb, 0x80000000u); }
        const float mn = fmaxf(m, tile_max(sacc)); float ps = 0.f;
#pragma unroll
        for (int kt = 0; kt < 4; ++kt)
#pragma unroll
            for (int r = 0; r < 4; ++r) ps += __builtin_amdgcn_exp2f(sacc[kt][r] - mn);
        l = l * __builtin_amdgcn_exp2f(m - mn) + ps; m = mn;
        pf_store<64, 16>(rk, NSA_KL(cb ^ 1), 272, tid); if (!hn) pf_store<64, 16>(rv, NSA_VL(cb ^ 1), 288, tid);
        lds_barrier(); cbuf ^= 1;
    }
    l += __shfl_xor(l, 16); l += __shfl_xor(l, 32);
    const float inv = (cnt_t > 0 && l > 0.f) ? 1.f / l : 0.f;
#pragma unroll
    for (int dt = 0; dt < 8; ++dt) oacc[dt] = (f32x4){0.f, 0.f, 0.f, 0.f};
#pragma unroll 1
    for (int T = 0; T < ntile; ++T) { const int cb = cbuf; const bool hn = T + 1 < ntile;
        if (hn) { pf_load<64, 16>(rk, kcb + (size_t)(T + 1) * 64 * 256, 256, tid); pf_load<64, 16>(rv, vcb + (size_t)(T + 1) * 64 * 256, 256, tid); }
        else { const char* kb = hb + H_NKS * 2; pf_load<64, 16>(rk, kb, (size_t)NP * 2, tid); pf_load<64, 16>(rv, kb + (H_NVS - H_NKS) * 2, (size_t)NP * 2, tid); }
        qk_tile(sacc, NSA_KL(cb), qf, i, grp);
        { const int nb = 64 * T + 4 * grp; const float c0 = -sl2 * (float)(t - 31 - 16 * nb);
          if (64 * T + 63 < cnt_min) score_tile<false>(sacc, sc2, 16.f * sl2, c0, 0, 0u); else score_tile<true>(sacc, sc2, 16.f * sl2, c0, cnt_t - 1 - nb, 0x80000000u); }
#pragma unroll
        for (int kt = 0; kt < 4; ++kt) {
#pragma unroll
            for (int r = 0; r < 4; ++r) sacc[kt][r] = __builtin_amdgcn_exp2f(sacc[kt][r] - m) * inv;
            f32x4 ps = sacc[kt];
#pragma unroll
            for (int r = 0; r < 4; ++r) { ps[r] += __shfl_xor(ps[r], 1); ps[r] += __shfl_xor(ps[r], 2); }
            const int j = 16 * T + 4 * kt + grp;
            if (r4 == 0) { IMPA[qi * 128 + j] = (ps[0] + ps[1]) + (ps[2] + ps[3]); if (j + 1 < 128) IMPB[qi * 128 + j + 1] = ps[3]; }
        }
        bf16x8 pf[2]; pf[0] = pack2(sacc[0], sacc[1]); pf[1] = pack2(sacc[2], sacc[3]);
        pv_tile(oacc, NSA_VL(cb), pf, lane, grp);
        pf_store<64, 16>(rk, NSA_KL(cb ^ 1), 272, tid); pf_store<64, 16>(rv, NSA_VL(cb ^ 1), 288, tid);
        lds_barrier(); cbuf ^= 1;
    }
#pragma unroll
    for (int dt = 0; dt < 8; ++dt) comb[dt] = comb[dt] + oacc[dt] * gate[0];

    { const int j0 = lane, j1 = lane + 64; unsigned k0[4], k1[4], T[4];
#pragma unroll
      for (int qq = 0; qq < 4; ++qq) { const int q = 4 * w + qq;
          const float v0 = (j0 == 0 || j0 == cur || j0 == cur - 1) ? 1e4f : (j0 <= cur ? IMPA[q * 128 + j0] + IMPB[q * 128 + j0] : -1.f);
          const float v1 = (j1 == cur || j1 == cur - 1) ? 1e4f : (j1 <= cur ? IMPA[q * 128 + j1] + IMPB[q * 128 + j1] : -1.f);
          const unsigned a0 = __float_as_uint(v0), a1 = __float_as_uint(v1);
          k0[qq] = (a0 & 0x80000000u) ? ~a0 : (a0 | 0x80000000u); k1[qq] = (a1 & 0x80000000u) ? ~a1 : (a1 | 0x80000000u); T[qq] = 0u; }
#pragma unroll 1
      for (int bit = 31; bit >= 0; --bit) {
#pragma unroll
          for (int qq = 0; qq < 4; ++qq) { const unsigned cand = T[qq] | (1u << bit);
              const int c = __popcll(__ballot(k0[qq] >= cand)) + __popcll(__ballot(k1[qq] >= cand));
              T[qq] = c >= 16 ? cand : T[qq]; } }
#pragma unroll
      for (int qq = 0; qq < 4; ++qq) { const int q = 4 * w + qq;
          const bool g0 = k0[qq] > T[qq], g1 = k1[qq] > T[qq], e0 = k0[qq] == T[qq], e1 = k1[qq] == T[qq];
          const int need = 16 - (__popcll(__ballot(g0)) + __popcll(__ballot(g1)));
          const unsigned long long m0 = __ballot(e0), m1 = __ballot(e1);
          const int r0 = (int)__builtin_amdgcn_mbcnt_hi((unsigned)(m0 >> 32), __builtin_amdgcn_mbcnt_lo((unsigned)m0, 0u));
          const int r1 = __popcll(m0) + (int)__builtin_amdgcn_mbcnt_hi((unsigned)(m1 >> 32), __builtin_amdgcn_mbcnt_lo((unsigned)m1, 0u));
          const unsigned long long b0 = __ballot(g0 || (e0 && r0 < need)), b1 = __ballot(g1 || (e1 && r1 < need));
          if (lane == 0) { SELM[q * 4 + 0] = (unsigned)b0; SELM[q * 4 + 1] = (unsigned)(b0 >> 32); SELM[q * 4 + 2] = (unsigned)b1; SELM[q * 4 + 3] = (unsigned)(b1 >> 32); } } }
    lds_barrier();
    unsigned u0 = 0u, u1 = 0u, u2 = 0u, u3 = 0u;
    for (int q = 0; q < 32; ++q) { u0 |= SELM[q * 4 + 0]; u1 |= SELM[q * 4 + 1]; u2 |= SELM[q * 4 + 2]; u3 |= SELM[q * 4 + 3]; }
    const unsigned mm0 = SELM[qi * 4 + 0], mm1 = SELM[qi * 4 + 1], mm2 = SELM[qi * 4 + 2], mm3 = SELM[qi * 4 + 3];
    u0 = __builtin_amdgcn_readfirstlane(u0 & (cur >= 31 ? 0xffffffffu : ((2u << cur) - 1u)));
    u1 = __builtin_amdgcn_readfirstlane(u1 & (cur >= 63 ? 0xffffffffu : (cur < 32 ? 0u : ((2u << (cur - 32)) - 1u))));
    u2 = __builtin_amdgcn_readfirstlane(u2 & (cur >= 95 ? 0xffffffffu : (cur < 64 ? 0u : ((2u << (cur - 64)) - 1u))));
    u3 = __builtin_amdgcn_readfirstlane(u3 & (cur >= 127 ? 0xffffffffu : (cur < 96 ? 0u : ((2u << (cur - 96)) - 1u))));

    m = MINIT; l = 0.f;
#pragma unroll
    for (int dt = 0; dt < 8; ++dt) oacc[dt] = (f32x4){0.f, 0.f, 0.f, 0.f};
    LAS int* LIST = (LAS int*)(F.lds + 104960);
    if (tid < 128) { const int p = tid; const unsigned wv = p < 32 ? u0 : (p < 64 ? u1 : (p < 96 ? u2 : u3));
        if ((wv >> (p & 31)) & 1u) { int idx = __popc(wv & ((1u << (p & 31)) - 1u)); if (p >= 32) idx += __popc(u0); if (p >= 64) idx += __popc(u1); if (p >= 96) idx += __popc(u2); LIST[idx] = p; } }
    const int nblk = __popc(u0) + __popc(u1) + __popc(u2) + __popc(u3);
    lds_barrier();
    { int j = 0;
#pragma unroll 1
      for (int it = 0; it < nblk; ++it) { const int cb = cbuf; const bool hn = it + 1 < nblk; const int jn = hn ? __builtin_amdgcn_readfirstlane(LIST[it + 1]) : 0;
          if (hn) { const char* kb = hb + (size_t)(64 * jn) * NP * 2 + H_NKS * 2;
              pf_load<64, 16>(rk, kb, (size_t)NP * 2, tid); pf_load<64, 16>(rv, kb + (H_NVS - H_NKS) * 2, (size_t)NP * 2, tid); }
          else { const char* kb = hb + (size_t)(64 * jlo) * NP * 2 + H_NKW * 2;
              pf_load<64, 16>(rk, kb, (size_t)NP * 2, tid); pf_load<64, 16>(rv, kb + (H_NVW - H_NKW) * 2, (size_t)NP * 2, tid); }
          qk_tile(sacc, NSA_KL(cb), qf, i, grp);
          const unsigned mw = j < 32 ? mm0 : (j < 64 ? mm1 : (j < 96 ? mm2 : mm3));
          const bool sel = (mw >> (j & 31)) & 1u;
          { const int dl = t - 64 * j - 4 * grp; const float c0 = sel ? -sl2 * (float)dl : NEGS;
            if (j < cur) score_tile<false>(sacc, sc2, sl2, c0, 0, 0u); else score_tile<true>(sacc, sc2, sl2, c0, dl, 0x80000000u); }
          online_tile(sacc, m, l, oacc, NSA_VL(cb), lane, grp);
          pf_store<64, 16>(rk, NSA_KL(cb ^ 1), 272, tid); pf_store<64, 16>(rv, NSA_VL(cb ^ 1), 288, tid);
          lds_barrier(); cbuf ^= 1;
          j = jn; } }
    l += __shfl_xor(l, 16); l += __shfl_xor(l, 32);
    { const float il = l > 0.f ? gate[1] / l : 0.f;
#pragma unroll
      for (int dt = 0; dt < 8; ++dt) comb[dt] = comb[dt] + oacc[dt] * il; }

    m = MINIT; l = 0.f;
#pragma unroll
    for (int dt = 0; dt < 8; ++dt) oacc[dt] = (f32x4){0.f, 0.f, 0.f, 0.f};
#pragma unroll 1
    for (int j = jlo; j <= cur; ++j) { const int cb = cbuf; const bool hn = j + 1 <= cur;
        if (hn) { const char* kb = hb + (size_t)(64 * (j + 1)) * NP * 2 + H_NKW * 2;
            pf_load<64, 16>(rk, kb, (size_t)NP * 2, tid); pf_load<64, 16>(rv, kb + (H_NVW - H_NKW) * 2, (size_t)NP * 2, tid); }
        qk_tile(sacc, NSA_KL(cb), qf, i, grp);
        { const int dl = t - 64 * j - 4 * grp; const float c0 = -sl2 * (float)dl;
          if (64 * j + 63 <= t0 && 64 * j >= t0 - 480) score_tile<false>(sacc, sc2, sl2, c0, 0, 0u); else score_tile<true>(sacc, sc2, sl2, c0, dl, 512u); }
        online_tile(sacc, m, l, oacc, NSA_VL(cb), lane, grp);
        if (hn) { pf_store<64, 16>(rk, NSA_KL(cb ^ 1), 272, tid); pf_store<64, 16>(rv, NSA_VL(cb ^ 1), 288, tid); }
        lds_barrier(); cbuf ^= 1;
    }
    l += __shfl_xor(l, 16); l += __shfl_xor(l, 32);
    { const float il = l > 0.f ? gate[2] / l : 0.f;
#pragma unroll
      for (int dt = 0; dt < 8; ++dt) comb[dt] = comb[dt] + oacc[dt] * il; }

    { const bf16* zrow = WSB(WS_H) + tok * NP + H_NZ + head * 128; bf16* orow = WSB(WS_GATED) + (size_t)1 * M * 2048 + tok * 2048 + head * 128;
#pragma unroll
      for (int dt = 0; dt < 8; ++dt) { const int d0 = 16 * dt + 4 * grp; const u32x2 z = *(const u32x2*)(zrow + d0);
          u32x2 o; o.x = cvtpk(comb[dt][0] * siluf_(bflo(z.x)), comb[dt][1] * siluf_(bfhi(z.x))); o.y = cvtpk(comb[dt][2] * siluf_(bflo(z.y)), comb[dt][3] * siluf_(bfhi(z.y)));
          *(u32x2*)(orow + d0) = o; } }
#undef NSA_KL
#undef NSA_VL
}
DI void ln_rows(Frame& F, const Args& A) {
    const int gw = F.bid * NWAVES + F.wave, NGW = F.G * NWAVES, lane = F.lane;
    for (int row = gw; row < M; row += NGW) {
        f32x4* rp = (f32x4*)(A.out + (size_t)row * DM) + lane;
        f32x4 v[16]; float s = 0.f;
#pragma unroll
        for (int j = 0; j < 16; ++j) { v[j] = rp[64 * j]; s += (v[j][0] + v[j][1]) + (v[j][2] + v[j][3]); }
        const float mean = wave_sum(s) * (1.f / DM); float q = 0.f;
#pragma unroll
        for (int j = 0; j < 16; ++j) { v[j] = v[j] - mean; q += (v[j][0] * v[j][0] + v[j][1] * v[j][1]) + (v[j][2] * v[j][2] + v[j][3] * v[j][3]); }
        const float rstd = rsqrtf(wave_sum(q) * (1.f / DM) + LN_EPS);
#pragma unroll
        for (int j = 0; j < 16; ++j) { const f32x4 gg = ((const f32x4*)IN_LNG(A))[lane + 64 * j], bb = ((const f32x4*)IN_LNB(A))[lane + 64 * j]; rp[64 * j] = v[j] * rstd * gg + bb; }
    }
}

constexpr int N_PHASES = 8;
__global__ void __launch_bounds__(NWAVES * 64, 2) mk_fwd(Args args) {
    extern __shared__ __attribute__((aligned(16))) unsigned char lds_raw[];
    Frame F;
    F.lds = (LAS unsigned char*)lds_raw;
    F.MISC = (volatile LAS unsigned*)(F.lds + MISC_OFF);
    F.tid = threadIdx.x; F.lane = F.tid & 63; F.wave = __builtin_amdgcn_readfirstlane(F.tid >> 6);
    F.G = gridDim.x; F.bid = blockIdx.x;
    F.ws = args.ws;
    F.ctl = (gu32*)(F.ws + WS_CTL);
    for (int u = F.tid; u < 64; u += NWAVES * 64) ((LAS unsigned*)(F.lds + MISC_OFF))[u] = 0u;
    __syncthreads();
    const int lo = args.ph_lo, hi = args.ph_hi;
    XcdBarrier bar; bar.bar = (unsigned*)(F.ctl + CW_BAR); bar.x = 0; bar.st = nullptr;
    if (hi - lo > 1) bar = xcd_barrier_post((unsigned*)(F.ctl + CW_BAR), F.MISC + 8);
#ifndef MK_PHASE_MASK
#define MK_PHASE_MASK 0xFF
#endif
#define IN(k) (((MK_PHASE_MASK >> (k)) & 1) && lo <= (k) && (k) < hi)
#define SEAM(k) do { if (IN(k) && IN((k) + 1)) xcd_barrier(bar); } while (0)

    if (IN(0)) { p0_prologue(F, args); }
    SEAM(0);
    if (IN(1)) {
        pg8::Gemm gm{WSB(WS_XB), WSB(WS_WINT), M + 512, NP + 4096, 4096}; pg8::H1Order S; S.init(F.G, F.bid); pg8::EpiH1 E{WSB(WS_H), NP, WSB(WS_KVMEM), 4096};
        pg8::gemm_phase<pg8::EpiH1, pg8::H1Order, true, true>(F.lds, gm, S, E);
    }
    SEAM(1);
    if (IN(2)) {
        for (;;) { const int it = wq_next(F, CW_Q2); if (it >= 64 + 512 + 1024) break;

#ifndef MK_NO_CMP
            if (it < 64) compress_item(F, it);
#endif
#ifndef MK_NO_MEM
            if (it >= 64 && it < 576) mem_attn_item(F, it - 64);
#endif
#ifndef MK_NO_PREP
            if (it >= 576) gla_prep_item(F, args, it - 576);
#endif
        }
    }
    SEAM(2);
    if (IN(3)) {
        const int x0 = (int)(xb_xcc_id() & 7u);
#pragma unroll 1
        for (int kq = 0; kq < 8; ++kq) { const int xq = (x0 + kq) & 7;
            for (;;) { const int li = wq_next(F, CW_Q3 + 64 * xq);
#ifdef MK_PROBE_ATT
                if (li >= 4 + 512) break;
#else
                if (li >= 4 + 256) break;
#endif
#ifndef MK_NO_SCAN
                if (li < 4) gla_scan_item(F, xq * 4 + li);
#endif
#ifndef MK_NO_ATT
                if (li >= 4) nsa_attend_item(F, xq * 256 + ((li - 4) & 255));
#endif
            } }
    }
    SEAM(3);
    if (IN(4)) { gla_finalize(F, args); }
    SEAM(4);
    if (IN(5)) {
        pg8::Gemm gm{WSB(WS_GATED), WSB(WS_WBRT), 3 * M, 3 * 4096, 2048}; pg8::MergeOrder S; S.init(F.G, F.bid); pg8::EpiMerge E{WSB(WS_H), NP, H_MRG, IN_BMERGE(args), WSB(WS_MERGED)};
        pg8::gemm_phase<pg8::EpiMerge, pg8::MergeOrder, true, true>(F.lds, gm, S, E);
    }
    SEAM(5);
    if (IN(6)) {
        pg8::Gemm gm{WSB(WS_MERGED), WSB(WS_WOUTT), M, 4096, 4096}; pg8::StaticOrder S; S.init(M, 4096, F.G, F.bid); pg8::EpiOut E{IN_X(args), args.out, ALPHA};
        pg8::gemm_phase<pg8::EpiOut, pg8::StaticOrder, true, true>(F.lds, gm, S, E);
    }
    SEAM(6);
    if (IN(7)) { ln_rows(F, args); }
#undef IN
#undef SEAM
}

extern "C" void kernel_launch(void* const* d_in, const int* in_sizes, int n_in, void* d_out, int out_size, void* d_ws, size_t ws_size, hipStream_t stream) {
    static int grid = 0;
    if (grid == 0) {
        if (n_in != 20 || in_sizes[0] != M * DM || out_size != M * DM || ws_size < WS_END) { fprintf(stderr, "kernel_launch: unexpected problem (n_in %d in0 %d out %d ws %zu); nothing launched\n", n_in, n_in > 0 ? in_sizes[0] : -1, out_size, ws_size); grid = -1; return; }
        int dev = 0, cus = 0, per_cu = 0;
        if (hipGetDevice(&dev) != hipSuccess || hipDeviceGetAttribute(&cus, hipDeviceAttributeMultiprocessorCount, dev) != hipSuccess) { grid = -1; return; }
        if (hipFuncSetAttribute((const void*)mk_fwd, hipFuncAttributeMaxDynamicSharedMemorySize, LDS_BYTES) != hipSuccess) { fprintf(stderr, "kernel_launch: hipFuncSetAttribute failed\n"); grid = -1; return; }
        if (hipOccupancyMaxActiveBlocksPerMultiprocessor(&per_cu, (const void*)mk_fwd, NWAVES * 64, LDS_BYTES) != hipSuccess || per_cu < 1) { fprintf(stderr, "kernel_launch: occupancy query reports %d blocks per CU\n", per_cu); (void)hipGetLastError(); grid = -1; return; }
        grid = cus;
    }
    if (grid < 0) return;
    if (hipMemsetAsync((char*)d_ws + WS_CTL, 0, CTL_ZERO_BYTES, stream) != hipSuccess) return;
    Args a{};
    for (int i = 0; i < 20; ++i) a.in[i] = (const float*)d_in[i];
    a.out = (float*)d_out; a.ws = (unsigned char*)d_ws;
#if MK_SINGLE
    a.ph_lo = 0; a.ph_hi = N_PHASES;
    hipLaunchKernelGGL(mk_fwd, dim3(grid), dim3(NWAVES * 64), LDS_BYTES, stream, a);
#else
    for (int p = 0; p < N_PHASES; ++p) { a.ph_lo = p; a.ph_hi = p + 1; hipLaunchKernelGGL(mk_fwd, dim3(grid), dim3(NWAVES * 64), LDS_BYTES, stream, a);
#ifdef MK_PROBE
        if (p == MK_PROBE) { (void)hipMemsetAsync((char*)d_ws + WS_CTL, 0, CTL_ZERO_BYTES, stream);
            if (MK_PROBE == 3) { a.ph_lo = 2; a.ph_hi = 3; hipLaunchKernelGGL(mk_fwd, dim3(grid), dim3(NWAVES * 64), LDS_BYTES, stream, a); a.ph_lo = 3; a.ph_hi = 4; }
            hipLaunchKernelGGL(mk_fwd, dim3(grid), dim3(NWAVES * 64), LDS_BYTES, stream, a); }
#endif
    }
#endif
}
```
